# Optimizing an MI355X kernel written in HIP

```python
import math
import jax, jax.numpy as jnp
from jax import lax
import numpy as np

D_MODEL = 1024
BATCH = 8
SEQ = 8192
DEPTH = 4

HEAD_DIM = 64
N_DIFF_HEADS = 4
DIFF_V_DIM = 2 * HEAD_DIM
N_FOX_HEADS = 8
D_DIFF_QK = N_DIFF_HEADS * HEAD_DIM
D_DIFF_OUT = N_DIFF_HEADS * DIFF_V_DIM
D_FOX = N_FOX_HEADS * HEAD_DIM
D_MIX = D_DIFF_OUT + D_FOX
D_IN = 4 * D_DIFF_QK + D_DIFF_OUT + 3 * D_FOX + N_FOX_HEADS
SPLIT_POINTS = (D_DIFF_QK, 2 * D_DIFF_QK, 3 * D_DIFF_QK, 4 * D_DIFF_QK,
                4 * D_DIFF_QK + D_DIFF_OUT,
                4 * D_DIFF_QK + D_DIFF_OUT + D_FOX,
                4 * D_DIFF_QK + D_DIFF_OUT + 2 * D_FOX,
                4 * D_DIFF_QK + D_DIFF_OUT + 3 * D_FOX)
ATTN_SCALE = 1.0 / math.sqrt(HEAD_DIM)
ROPE_DIM = HEAD_DIM // 4
ROPE_THETA = 500000.0
Q_BLOCK = 128
N_MEM = 256
MEM_HEADS = 4
MEM_HEAD_DIM = D_MODEL // MEM_HEADS
MEM_SCALE = 1.0 / math.sqrt(MEM_HEAD_DIM)
D_FF = 2816
N_EXPERTS = 8
TOP_K = 2
D_EXPERT = 3584
N_DENSE = (DEPTH + 1) // 2
N_MOE = DEPTH // 2
EPS = 1e-6
SUBLN_EPS = 1e-5

kernel_name = "hybrid_diff_fox_moe_trunk"


def rmsnorm(x, g, eps=EPS):
    xf = x.astype(jnp.float32)
    y = xf * lax.rsqrt(jnp.mean(xf * xf, axis=-1, keepdims=True) + eps)
    return (y * g.astype(jnp.float32)).astype(x.dtype)


def rope_tables(positions, dtype):
    inv_freq = ROPE_THETA ** (-jnp.arange(0, ROPE_DIM, 2, dtype=jnp.float32) / ROPE_DIM)
    ang = positions.astype(jnp.float32)[..., None] * inv_freq
    return (jnp.cos(ang)[:, :, None, :].astype(dtype),
            jnp.sin(ang)[:, :, None, :].astype(dtype))


def apply_partial_rope(t, cos, sin):
    half = ROPE_DIM // 2
    t1, t2, rest = t[..., :half], t[..., half:ROPE_DIM], t[..., ROPE_DIM:]
    return jnp.concatenate([t1 * cos - t2 * sin, t2 * cos + t1 * sin, rest], axis=-1)


def hybrid_mixer(h, cos, sin, w_in, lam_q1, lam_k1, lam_q2, lam_k2, diff_subln_g, fox_bias, w_out, lam_init):
    B, S, _ = h.shape
    proj = h @ w_in
    q1, q2, k1, k2, v_d, q_f, k_f, v_f, f_logit = jnp.split(proj, SPLIT_POINTS, axis=-1)
    hd = lambda t, n: t.reshape(B, S, n, -1)
    q1 = apply_partial_rope(hd(q1, N_DIFF_HEADS), cos, sin)
    q2 = apply_partial_rope(hd(q2, N_DIFF_HEADS), cos, sin)
    k1 = apply_partial_rope(hd(k1, N_DIFF_HEADS), cos, sin)
    k2 = apply_partial_rope(hd(k2, N_DIFF_HEADS), cos, sin)
    v_d = hd(v_d, N_DIFF_HEADS)
    q_f, k_f, v_f = hd(q_f, N_FOX_HEADS), hd(k_f, N_FOX_HEADS), hd(v_f, N_FOX_HEADS)

    lam = (jnp.exp(jnp.sum(lam_q1.astype(jnp.float32) * lam_k1.astype(jnp.float32)))
           - jnp.exp(jnp.sum(lam_q2.astype(jnp.float32) * lam_k2.astype(jnp.float32)))
           + lam_init)

    log_f = jax.nn.log_sigmoid((f_logit + fox_bias).astype(jnp.float32))
    c = lax.cumsum(log_f, axis=1)
    c_k = jnp.transpose(c, (0, 2, 1))[:, :, None, :]

    nb = S // Q_BLOCK
    key_idx = jnp.arange(S)

    def to_blocks(t):
        return jnp.moveaxis(t.reshape(B, nb, Q_BLOCK, *t.shape[2:]), 1, 0)

    def from_blocks(t):
        return jnp.moveaxis(t, 0, 1).reshape(B, S, *t.shape[3:])

    def block(args):
        qb1, qb2, qbf, cb, start = args
        causal = key_idx[None, :] <= (start + jnp.arange(Q_BLOCK))[:, None]
        s1 = jnp.einsum('bqhd,bkhd->bhqk', qb1, k1).astype(jnp.float32) * ATTN_SCALE
        s2 = jnp.einsum('bqhd,bkhd->bhqk', qb2, k2).astype(jnp.float32) * ATTN_SCALE
        p1 = jax.nn.softmax(jnp.where(causal, s1, -jnp.inf), axis=-1)
        p2 = jax.nn.softmax(jnp.where(causal, s2, -jnp.inf), axis=-1)
        o_d = jnp.einsum('bhqk,bkhe->bqhe', (p1 - lam * p2).astype(v_d.dtype), v_d)
        sf = (jnp.einsum('bqhd,bkhd->bhqk', qbf, k_f).astype(jnp.float32) * ATTN_SCALE
              + jnp.transpose(cb, (0, 2, 1))[..., None] - c_k)
        pf = jax.nn.softmax(jnp.where(causal, sf, -jnp.inf), axis=-1)
        o_f = jnp.einsum('bhqk,bkhd->bqhd', pf.astype(v_f.dtype), v_f)
        return o_d, o_f

    o_d, o_f = lax.map(block, (to_blocks(q1), to_blocks(q2), to_blocks(q_f), to_blocks(c),
                               jnp.arange(nb) * Q_BLOCK))
    o_d = rmsnorm(from_blocks(o_d), diff_subln_g, SUBLN_EPS) * (1.0 - lam_init)
    o_f = from_blocks(o_f)
    mixed = jnp.concatenate([o_d.reshape(B, S, D_DIFF_OUT), o_f.reshape(B, S, D_FOX)], axis=-1)
    return mixed @ w_out


def memory_cross_attention(h, mem_n, w_q, w_kv, w_o):
    B, S, _ = h.shape
    q = (h @ w_q).reshape(B, S, MEM_HEADS, MEM_HEAD_DIM)
    k, v = jnp.split(mem_n @ w_kv, 2, axis=-1)
    k = k.reshape(B, N_MEM, MEM_HEADS, MEM_HEAD_DIM)
    v = v.reshape(B, N_MEM, MEM_HEADS, MEM_HEAD_DIM)
    s = jnp.einsum('bqhd,bmhd->bhqm', q, k).astype(jnp.float32) * MEM_SCALE
    p = jax.nn.softmax(s, axis=-1).astype(v.dtype)
    o = jnp.einsum('bhqm,bmhd->bqhd', p, v).reshape(B, S, D_MODEL)
    return o @ w_o


def dense_swiglu(h, w1, w3, w2):
    return (jax.nn.silu(h @ w1) * (h @ w3)) @ w2


def moe_swiglu(h, w_router, w1, w3, w2):
    B, S, D = h.shape
    xt = h.reshape(B * S, D)
    logits = (xt @ w_router).astype(jnp.float32)
    top_vals, top_idx = lax.top_k(logits, TOP_K)
    gates = jax.nn.softmax(top_vals, axis=-1)
    combine = jnp.sum(jax.nn.one_hot(top_idx, N_EXPERTS, dtype=jnp.float32) * gates[..., None], axis=1)
    combine = combine.astype(h.dtype)
    y = jnp.zeros_like(xt)
    for e in range(N_EXPERTS):
        y = y + combine[:, e:e + 1] * ((jax.nn.silu(xt @ w1[e]) * (xt @ w3[e])) @ w2[e])
    return y.reshape(B, S, D)


def setup_inputs(seed: int = 0) -> dict:
    key = jax.random.key(seed)
    ks = jax.random.split(key, 32)
    f32 = jnp.float32
    nrm = lambda k, shape, fan_in: jax.random.normal(k, shape, f32) * (fan_in ** -0.5)
    gain = lambda k, shape: 1.0 + 0.02 * jax.random.normal(k, shape, f32)
    x = jax.random.normal(ks[0], (BATCH, SEQ, D_MODEL), f32)
    mem = jax.random.normal(ks[1], (BATCH, N_MEM, D_MODEL), f32)
    offsets = jax.random.randint(ks[2], (BATCH, 1), 0, 4096, dtype=jnp.int32)
    positions = offsets + jnp.arange(SEQ, dtype=jnp.int32)[None, :]
    return {
        "x": x,
        "mem": mem,
        "positions": positions,
        "norm_mix_g": gain(ks[3], (DEPTH, D_MODEL)),
        "w_in": nrm(ks[4], (DEPTH, D_MODEL, D_IN), D_MODEL),
        "lam_q1": 0.1 * jax.random.normal(ks[5], (DEPTH, HEAD_DIM), f32),
        "lam_k1": 0.1 * jax.random.normal(ks[6], (DEPTH, HEAD_DIM), f32),
        "lam_q2": 0.1 * jax.random.normal(ks[7], (DEPTH, HEAD_DIM), f32),
        "lam_k2": 0.1 * jax.random.normal(ks[8], (DEPTH, HEAD_DIM), f32),
        "diff_subln_g": gain(ks[9], (DEPTH, DIFF_V_DIM)),
        "fox_bias": 3.0 + 0.1 * jax.random.normal(ks[10], (DEPTH, N_FOX_HEADS), f32),
        "w_out": nrm(ks[11], (DEPTH, D_MIX, D_MODEL), D_MIX),
        "norm_mem_g": gain(ks[12], (DEPTH, D_MODEL)),
        "mem_norm_g": gain(ks[13], (DEPTH, D_MODEL)),
        "w_mq": nrm(ks[14], (DEPTH, D_MODEL, D_MODEL), D_MODEL),
        "w_mkv": nrm(ks[15], (DEPTH, D_MODEL, 2 * D_MODEL), D_MODEL),
        "w_mo": nrm(ks[16], (DEPTH, D_MODEL, D_MODEL), D_MODEL),
        "norm_ffn_g": gain(ks[17], (DEPTH, D_MODEL)),
        "w_ff1": nrm(ks[18], (N_DENSE, D_MODEL, D_FF), D_MODEL),
        "w_ff3": nrm(ks[19], (N_DENSE, D_MODEL, D_FF), D_MODEL),
        "w_ff2": nrm(ks[20], (N_DENSE, D_FF, D_MODEL), D_FF),
        "w_router": nrm(ks[21], (N_MOE, D_MODEL, N_EXPERTS), D_MODEL),
        "w_e1": nrm(ks[22], (N_MOE, N_EXPERTS, D_MODEL, D_EXPERT), D_MODEL),
        "w_e3": nrm(ks[23], (N_MOE, N_EXPERTS, D_MODEL, D_EXPERT), D_MODEL),
        "w_e2": nrm(ks[24], (N_MOE, N_EXPERTS, D_EXPERT, D_MODEL), D_EXPERT),
        "final_norm_g": gain(ks[25], (D_MODEL,)),
    }


def reference(x, mem, positions, norm_mix_g, w_in, lam_q1, lam_k1, lam_q2, lam_k2, diff_subln_g,
              fox_bias, w_out, norm_mem_g, mem_norm_g, w_mq, w_mkv, w_mo, norm_ffn_g,
              w_ff1, w_ff3, w_ff2, w_router, w_e1, w_e3, w_e2, final_norm_g):
    cos, sin = rope_tables(positions, x.dtype)
    h = x
    for l in range(DEPTH):
        lam_init = 0.8 - 0.6 * math.exp(-0.3 * l)
        h = h + hybrid_mixer(rmsnorm(h, norm_mix_g[l]), cos, sin, w_in[l], lam_q1[l], lam_k1[l],
                             lam_q2[l], lam_k2[l], diff_subln_g[l], fox_bias[l], w_out[l], lam_init)
        h = h + memory_cross_attention(rmsnorm(h, norm_mem_g[l]), rmsnorm(mem, mem_norm_g[l]),
                                       w_mq[l], w_mkv[l], w_mo[l])
        hn = rmsnorm(h, norm_ffn_g[l])
        if l % 2 == 0:
            i = l // 2
            h = h + dense_swiglu(hn, w_ff1[i], w_ff3[i], w_ff2[i])
        else:
            i = l // 2
            h = h + moe_swiglu(hn, w_router[i], w_e1[i], w_e3[i], w_e2[i])
    return rmsnorm(h, final_norm_g)
```

```cpp
#include <hip/hip_runtime.h>
#include <hip/hip_bf16.h>
#include <cstdio>
#include <cstdint>
#include <cmath>

constexpr int NB = 8, SEQ = 8192, DM = 1024, T = NB * SEQ, DEPTH = 4;
constexpr int D_IN = 3080, D_INP = 3328, QKVP = 3072;
constexpr int NMEM = 256, D_FF = 2816, NEXP = 8, D_EXP = 3584;
constexpr float EPS = 1e-6f, SUBLN_EPS = 1e-5f;
constexpr float LOG2E = 1.4426950408889634f;
constexpr float C2 = 0.125f * LOG2E;
constexpr float CM = 0.0625f * LOG2E;
constexpr int MOE_ROWS = 67584;
constexpr int MOE_TMAX = 264;

namespace pg8 {
#define PG8_LAS __attribute__((address_space(3)))
typedef unsigned short bf16_t;
typedef short bf16x8 __attribute__((ext_vector_type(8)));
typedef float f32x4 __attribute__((ext_vector_type(4)));
typedef float f32x2 __attribute__((ext_vector_type(2)));
typedef unsigned u32x4 __attribute__((ext_vector_type(4)));
typedef __bf16 bf16x2_t __attribute__((ext_vector_type(2)));
typedef int v4i_t __attribute__((ext_vector_type(4)));
typedef unsigned u32x2 __attribute__((ext_vector_type(2)));
constexpr int BM = 256, BK = 64, HALF = 128, HTB = HALF * BK * 2, STAGE_BYTES = 8 * HTB, NXCD = 8, WGM = 4;

__host__ __device__ __forceinline__ int lds_byte(int r, int c) { const int st = (r >> 4) * 2 + (c >> 5), rr = r & 15, cc = c & 31, ob = rr * 64 + cc * 2; return st * 1024 + (ob ^ (((ob >> 9) & 1) << 5)); }
__host__ __device__ __forceinline__ void stage_rc(int b, int& R, int& C) { const int st = b / 1024, sb = b % 1024, swz = sb ^ (((sb >> 9) & 1) << 5); R = (st >> 1) * 16 + swz / 64; C = (st & 1) * 32 + (swz % 64) / 2; }
__host__ __device__ __forceinline__ int perm32(int rho) { const int n = rho >> 4, i = rho & 15; return 8 * (i >> 2) + 4 * n + (i & 3); }

struct Unit { int pm, pn; const char* a; const char* b; char* o; int aux; const int* ridx; int last; };
struct Gemm { int lda, ldb, K; };

__device__ __forceinline__ bool tile_of(long L, int nM, int nN, int& pm, int& pn);
__device__ __forceinline__ bool tile_order(int i, int G, int c, int nM, int nN, int& pm, int& pn) { return tile_of((long)i * G + c, nM, nN, pm, pn); }
__device__ __forceinline__ bool tile_of(long L, int nM, int nN, int& pm, int& pn) {
    const int nwg = nM * nN; if (L >= nwg) return false;
    int wgid = (int)L; { const int q = nwg / NXCD, r = nwg % NXCD, xcd = wgid % NXCD, off = wgid / NXCD; wgid = (xcd < r ? xcd * (q + 1) : r * (q + 1) + (xcd - r) * q) + off; }
    const int nig = WGM * nN, gid = wgid / nig, fm = gid * WGM, gsz = (nM - fm) < WGM ? (nM - fm) : WGM;
    pm = fm + ((wgid % nig) % gsz); pn = (wgid % nig) / gsz; return true;
}

__device__ __forceinline__ unsigned cvt_pk(float lo, float hi) { f32x2 v = {lo, hi}; bf16x2_t b = __builtin_convertvector(v, bf16x2_t); return __builtin_bit_cast(unsigned, b); }
__device__ __forceinline__ float bf_lo(unsigned u) { return __uint_as_float(u << 16); }
__device__ __forceinline__ float bf_hi(unsigned u) { return __uint_as_float(u & 0xffff0000u); }
__device__ __forceinline__ u32x4 pack8(const f32x4 a, const f32x4 b) { u32x4 w; w.x = cvt_pk(a[0], a[1]); w.y = cvt_pk(a[2], a[3]); w.z = cvt_pk(b[0], b[1]); w.w = cvt_pk(b[2], b[3]); return w; }

__device__ __forceinline__ float rstd_of(float ssq) { return rsqrtf(ssq * (1.0f / 1024.0f) + EPS); }
template <class P> __device__ __forceinline__ float rstd16(P p) { const f32x4 a = p[0], b = p[1], c = p[2], d = p[3]; return rstd_of((((a[0] + a[1]) + (a[2] + a[3])) + ((b[0] + b[1]) + (b[2] + b[3]))) + (((c[0] + c[1]) + (c[2] + c[3])) + ((d[0] + d[1]) + (d[2] + d[3])))); }

typedef f32x4 AccT[2][2][4][2];

#define PG8_GAS __attribute__((address_space(1)))
struct RsPend { f32x4 a, b; };
__device__ __forceinline__ RsPend park_load(const float* ssq, unsigned row, int tid) {
    const PG8_GAS f32x4* p = (const PG8_GAS f32x4*)((const PG8_GAS char*)ssq + (size_t)row * 64u + (tid & 1) * 32u); RsPend r; r.a = p[0]; r.b = p[1]; return r; }
__device__ __forceinline__ void park_store(const RsPend& r, PG8_LAS float* rs, int tid) {
    float v = ((r.a[0] + r.a[1]) + (r.a[2] + r.a[3])) + ((r.b[0] + r.b[1]) + (r.b[2] + r.b[3]));
    v += __int_as_float(__builtin_amdgcn_update_dpp(0, __float_as_int(v), 0xB1, 0xf, 0xf, false));
    if ((tid & 1) == 0) rs[tid >> 1] = rstd_of(v); }
__device__ __forceinline__ RsPend park_none() { RsPend r; r.a = (f32x4){0.f, 0.f, 0.f, 0.f}; r.b = r.a; return r; }
template <class E_, class = void> struct HasLateRs { static constexpr bool value = false; };
template <class E_> struct HasLateRs<E_, decltype((void)E_::LATE_RS)> { static constexpr bool value = true; };
template <class Epi, class Sched, bool GATHER, bool F8 = false>
__device__ __forceinline__ void gemm_phase(PG8_LAS unsigned char* lds, const Gemm g, const Sched& S, const Epi& E, PG8_LAS float* rsbuf) {
    int tid_ = threadIdx.x; asm volatile("" : "+v"(tid_));
    const int tid = tid_, wid = __builtin_amdgcn_readfirstlane(tid >> 6), lane = tid & 63, wr = wid >> 2, wc = wid & 3, fr = lane & 15, fq = lane >> 4;
    const int K = g.K, nt = K / BK;
    int Rs[2], Cs[2];
    unsigned voffB[2], voffC[2][2], voffN[2][2];
#pragma unroll
    for (int i = 0; i < 2; ++i) { stage_rc(tid * 16 + i * 8192, Rs[i], Cs[i]); const int Rb = (Rs[i] & ~31) + perm32(Rs[i] & 31);
        voffB[i] = (unsigned)(Rb * g.ldb + Cs[i]) * 2u; }
    const size_t kstep = (size_t)(BK * 2);
    const size_t hstepB = (size_t)HALF * g.ldb * 2;
    const unsigned ldsw = (unsigned)wid * 1024u;
    const int aoff = lds_byte(wr * 64 + fr, fq * 8), boff = lds_byte(wc * 32 + fr, fq * 8);
#define PG8_SA(b, h) (((b) * 2 + (h)) * HTB)
#define PG8_SB(b, h) ((4 + (b) * 2 + (h)) * HTB)
#define PG8_STAGE(bufoff, gbase, v0, v1) do { \
        __builtin_amdgcn_global_load_lds((const unsigned*)((const char*)(gbase) + (v0)), (PG8_LAS unsigned*)(lds + (bufoff) + ldsw), 16, 0, 0); \
        __builtin_amdgcn_global_load_lds((const unsigned*)((const char*)(gbase) + (v1)), (PG8_LAS unsigned*)(lds + (bufoff) + ldsw + 8192), 16, 0, 0); } while (0)
#define PG8_STAGE_B(bufoff, gbase) PG8_STAGE(bufoff, gbase, voffB[0], voffB[1])
#define PG8_LDA(dst, b, h) do { _Pragma("unroll") for (int m = 0; m < 4; ++m) _Pragma("unroll") for (int k = 0; k < 2; ++k) dst[m][k] = *(const PG8_LAS bf16x8*)(lds + PG8_SA(b, h) + aoff + m * 2048 + k * 1024); } while (0)
#define PG8_LDB(dst, b, h) do { _Pragma("unroll") for (int n = 0; n < 2; ++n) _Pragma("unroll") for (int k = 0; k < 2; ++k) dst[n][k] = *(const PG8_LAS bf16x8*)(lds + PG8_SB(b, h) + boff + n * 2048 + k * 1024); } while (0)
#define PG8_CAT(x0, x1) __builtin_shufflevector(__builtin_bit_cast(v4i_t, x0), __builtin_bit_cast(v4i_t, x1), 0, 1, 2, 3, 4, 5, 6, 7)
#define PG8_MMA(ai, bj, At, Bt, Z) do { __builtin_amdgcn_s_setprio(1); _Pragma("unroll") for (int m = 0; m < 4; ++m) _Pragma("unroll") for (int n = 0; n < 2; ++n) { \
        if constexpr (F8) { if constexpr (Z) asm volatile("v_mfma_f32_16x16x128_f8f6f4 %0, %1, %2, 0" : "=&v"(acc[ai][bj][m][n]) : "v"(PG8_CAT(Bt[n][0], Bt[n][1])), "v"(PG8_CAT(At[m][0], At[m][1]))); \
            else asm volatile("v_mfma_f32_16x16x128_f8f6f4 %0, %1, %2, %0" : "+v"(acc[ai][bj][m][n]) : "v"(PG8_CAT(Bt[n][0], Bt[n][1])), "v"(PG8_CAT(At[m][0], At[m][1]))); }   \
        else { if constexpr (Z) asm volatile("v_mfma_f32_16x16x32_bf16 %0, %1, %2, 0" : "=&v"(acc[ai][bj][m][n]) : "v"(Bt[n][0]), "v"(At[m][0])); \
               else asm volatile("v_mfma_f32_16x16x32_bf16 %0, %1, %2, %0" : "+v"(acc[ai][bj][m][n]) : "v"(Bt[n][0]), "v"(At[m][0])); \
               asm volatile("v_mfma_f32_16x16x32_bf16 %0, %1, %2, %0" : "+v"(acc[ai][bj][m][n]) : "v"(Bt[n][1]), "v"(At[m][1])); } } \
        __builtin_amdgcn_s_setprio(0); } while (0)
#define PG8_WAIT_V(n) asm volatile("s_waitcnt vmcnt(" #n ")" ::: "memory")
#define PG8_WAIT_L(n) asm volatile("s_waitcnt lgkmcnt(" #n ")" ::: "memory")
#define PG8_BAR __builtin_amdgcn_s_barrier()
#define PG8_SCHED __builtin_amdgcn_sched_barrier(0)
#define PG8_VOFF(dst, u) do { _Pragma("unroll") for (int h = 0; h < 2; ++h) _Pragma("unroll") for (int i = 0; i < 2; ++i) { \
        int row_ = h * HALF + Rs[i]; if (GATHER) { row_ = *(const int*)((const char*)(u).ridx + (unsigned)(row_ * 4)); row_ = row_ < 0 ? 0 : row_; } dst[h][i] = (unsigned)(row_ * g.lda + Cs[i]) * 2u; } } while (0)
#define PG8_VRAW(dst, u) do { _Pragma("unroll") for (int h = 0; h < 2; ++h) _Pragma("unroll") for (int i = 0; i < 2; ++i) \
        dst[h][i] = (unsigned)*(const int*)((const char*)(u).ridx + (unsigned)((h * HALF + Rs[i]) * 4)); } while (0)
#define PG8_VCONV(raw, i) ((unsigned)(((int)(raw) < 0 ? 0 : (int)(raw)) * g.lda + Cs[i]) * 2u)
    Unit cur, nxt; int ui = 0;
    if (!S.next(0, cur)) return;
    f32x4 acc[2][2][4][2];
    bf16x8 At[4][2], B0[2][2], B1[2][2];
    PG8_VOFF(voffC, cur);
    const char* cA = cur.a; const char* cB = cur.b;
    PG8_STAGE_B(PG8_SB(0, 0), cB); PG8_STAGE_B(PG8_SB(0, 1), cB + hstepB); PG8_STAGE(PG8_SA(0, 0), cA, voffC[0][0], voffC[0][1]); PG8_STAGE(PG8_SA(0, 1), cA, voffC[1][0], voffC[1][1]);
    if (wr == 1) PG8_BAR;
    PG8_WAIT_V(2); PG8_BAR;
    PG8_STAGE_B(PG8_SB(1, 0), cB + kstep); PG8_STAGE(PG8_SA(1, 0), cA + kstep, voffC[0][0], voffC[0][1]); PG8_STAGE_B(PG8_SB(1, 1), cB + hstepB + kstep);
    PG8_WAIT_V(6); PG8_BAR;
    { const RsPend pv0 = E.pre_load(cur, tid); E.pre_store(pv0, rsbuf, tid); }
    for (;;) {
        const bool has_next = S.next(ui + 1, nxt);
        const char* nA = has_next ? nxt.a : cA; const char* nB = has_next ? nxt.b : cB;
        if constexpr (GATHER) { if (has_next) { PG8_VRAW(voffN, nxt); } else {
#pragma unroll
            for (int h = 0; h < 2; ++h)
#pragma unroll
                for (int i = 0; i < 2; ++i) voffN[h][i] = voffC[h][i]; } }
#define PG8_KBODY(T_, Z_) do { const int t = (T_); \
            const bool last = (t == nt - 2); \
            const char* a1 = cA + (size_t)(t + 1) * kstep; \
            const char* a2 = last ? nA : cA + (size_t)(t + 2) * kstep; const char* b2 = last ? nB : cB + (size_t)(t + 2) * kstep; \
            const char* a3 = a2 + kstep; const char* b3 = b2 + kstep; \
            unsigned v2[2][2]; \
            _Pragma("unroll") for (int h = 0; h < 2; ++h) _Pragma("unroll") for (int i = 0; i < 2; ++i) { v2[h][i] = voffC[h][i]; if (GATHER && last && has_next) { voffN[h][i] = PG8_VCONV(voffN[h][i], i); v2[h][i] = voffN[h][i]; } } \
              \
            PG8_LDB(B0, 0, 0); PG8_LDB(B1, 0, 1); PG8_SCHED; PG8_LDA(At, 0, 0); PG8_STAGE(PG8_SA(1, 1), a1, voffC[1][0], voffC[1][1]); \
            PG8_WAIT_V(8); PG8_WAIT_L(0); PG8_BAR; PG8_MMA(0, 0, At, B0, Z_); PG8_MMA(0, 1, At, B1, Z_); PG8_BAR; PG8_SCHED; \
              \
            PG8_LDA(At, 0, 1); PG8_STAGE_B(PG8_SB(0, 0), b2); PG8_STAGE_B(PG8_SB(0, 1), b2 + hstepB); PG8_STAGE(PG8_SA(0, 0), a2, v2[0][0], v2[0][1]); \
            PG8_WAIT_V(8); PG8_WAIT_L(0); PG8_BAR; PG8_MMA(1, 0, At, B0, Z_); PG8_MMA(1, 1, At, B1, Z_); PG8_BAR; PG8_SCHED; \
              \
            PG8_LDB(B0, 1, 0); PG8_LDB(B1, 1, 1); PG8_SCHED; PG8_LDA(At, 1, 0); PG8_STAGE(PG8_SA(0, 1), a2, v2[1][0], v2[1][1]); \
            PG8_WAIT_V(8); PG8_WAIT_L(0); PG8_BAR; PG8_MMA(0, 0, At, B0, false); PG8_MMA(0, 1, At, B1, false); PG8_BAR; PG8_SCHED; \
              \
            PG8_LDA(At, 1, 1); PG8_STAGE_B(PG8_SB(1, 0), b3); PG8_STAGE_B(PG8_SB(1, 1), b3 + hstepB); PG8_STAGE(PG8_SA(1, 0), a3, v2[0][0], v2[0][1]); \
            PG8_WAIT_V(8); PG8_WAIT_L(0); PG8_BAR; PG8_MMA(1, 0, At, B0, false); PG8_MMA(1, 1, At, B1, false); PG8_BAR; PG8_SCHED; } while (0)
        PG8_KBODY(0, true);
#pragma nounroll
        for (int t2 = 2; t2 < nt; t2 += 2) PG8_KBODY(t2, false);
        if (wr == 0) PG8_BAR;
        asm volatile("s_nop 15\n\ts_nop 15" ::: "memory");
        { int tid_e = threadIdx.x; asm volatile("" : "+v"(tid_e)); const int fr_e = tid_e & 15, fq_e = (tid_e >> 4) & 3;
          constexpr bool late_rs = HasLateRs<Epi>::value;
          cur.last = has_next ? 0 : 1;
          RsPend pv = park_none(); if (!late_rs && has_next) pv = E.pre_load(nxt, tid_e);
          E(acc, cur, wr, wc, fr_e, fq_e, rsbuf + (ui & 1) * 256);
          if (late_rs && has_next) pv = E.pre_load(nxt, tid_e);
          if (has_next) E.pre_store(pv, rsbuf + ((ui + 1) & 1) * 256, tid_e); }
        if (!has_next) break;
        cur = nxt; cA = nA; cB = nB; ++ui;
        if constexpr (GATHER) {
#pragma unroll
        for (int h = 0; h < 2; ++h)
#pragma unroll
            for (int i = 0; i < 2; ++i) voffC[h][i] = voffN[h][i]; }
        if (wr == 1) PG8_BAR;
    }
    PG8_WAIT_V(0);
    PG8_BAR;
#undef PG8_KBODY
#undef PG8_SA
#undef PG8_SB
#undef PG8_STAGE
#undef PG8_STAGE_B
#undef PG8_LDA
#undef PG8_LDB
#undef PG8_MMA
#undef PG8_CAT
#undef PG8_WAIT_V
#undef PG8_WAIT_L
#undef PG8_BAR
#undef PG8_SCHED
#undef PG8_VOFF
#undef PG8_VRAW
#undef PG8_VCONV
}

template <class V_, class P_> __device__ __forceinline__ void PG8_STORE(const V_& v_, P_ p_, int last_ = 0) { if (last_) __builtin_nontemporal_store(v_, p_); else *p_ = v_; }
#define PG8_AT(T_, base, off) ((PG8_GAS T_*)((PG8_GAS char*)(base) + (unsigned)(off)))
#define PG8_ATC(T_, base, off) ((const PG8_GAS T_*)((const PG8_GAS char*)(base) + (unsigned)(off)))

__device__ __forceinline__ unsigned pk_fp8x4(float a, float b, float c, float d) { int v = 0; v = __builtin_amdgcn_cvt_pk_fp8_f32(a, b, v, false); v = __builtin_amdgcn_cvt_pk_fp8_f32(c, d, v, true); return (unsigned)v; }
constexpr float F8_W1 = 32.f, F8_W2 = 64.f, F8_U = 4.f, F8_P = 256.f, F8_X = 8.f;
struct EpiIn {
    bf16_t* QKV; const float* ssq; const float* cs; const float* sn; float* logf; const float* fbias; unsigned* kmx;
    __device__ __forceinline__ RsPend pre_load(const Unit& u, int tid) const { return park_load(ssq, (unsigned)(u.pm * BM + (tid >> 1)), tid); }
    __device__ __forceinline__ void pre_store(const RsPend& r, PG8_LAS float* rs, int tid) const { park_store(r, rs, tid); }
    __device__ __forceinline__ void operator()(const AccT& acc, const Unit& u, int wr, int wc, int fr, int fq, const PG8_LAS float* rsl) const {
        const unsigned rl = (unsigned)(wr * 64 + fr);
        const bool knorm = (u.pn == 8 || u.pn == 9); float kx[2] = {0.f, 0.f};
        const float* ssqb = ssq + (size_t)u.pm * BM * 16;
        if (u.pn == 12) {
            if (wc == 0 && fq == 0) {
                const f32x4 b0 = *(const f32x4*)(fbias), b1 = *(const f32x4*)(fbias + 4);
                float* lb = logf + (size_t)u.pm * BM * 8;
#pragma unroll
                for (int ai = 0; ai < 2; ++ai)
#pragma unroll
                    for (int m = 0; m < 4; ++m) { const unsigned r = rl + ai * HALF + m * 16; const float rs = rsl[r];
                        f32x4 x0 = acc[ai][0][m][0] * rs + b0, x1 = acc[ai][0][m][1] * rs + b1, y0, y1;
#pragma unroll
                        for (int k = 0; k < 4; ++k) { y0[k] = fminf(x0[k], 0.f) - log1pf(__expf(-fabsf(x0[k]))); y1[k] = fminf(x1[k], 0.f) - log1pf(__expf(-fabsf(x1[k]))); }
                        *PG8_AT(f32x4, lb, r * 32u) = y0; *PG8_AT(f32x4, lb, r * 32u + 16u) = y1; }
            }
            return;
        }
        const float sc = (u.pn < 2 || u.pn == 6 || u.pn == 7) ? C2 : 1.f;
        const bool rope = (u.pn < 4) && ((wc & 1) == 0);
        const float sgn = (fq == 0) ? -1.f : 1.f;
        bf16_t* ob = QKV + (size_t)u.pm * BM * QKVP + u.pn * BM;
        const float* csb = cs + (size_t)u.pm * BM * 8; const float* snb = sn + (size_t)u.pm * BM * 8;
        const unsigned co = (unsigned)(wc * 32 + 8 * fq) * 2u;
#pragma unroll
        for (int ai = 0; ai < 2; ++ai)
#pragma unroll
            for (int m = 0; m < 4; ++m) { const unsigned r = rl + ai * HALF + m * 16; const float rs = rsl[r];
                f32x4 c0 = {1.f, 1.f, 1.f, 1.f}, c1 = c0, s0 = {0.f, 0.f, 0.f, 0.f}, s1 = s0;
                if (rope && fq < 2) { c0 = *PG8_ATC(f32x4, csb, r * 32u); c1 = *PG8_ATC(f32x4, csb, r * 32u + 16u); s0 = *PG8_ATC(f32x4, snb, r * 32u); s1 = *PG8_ATC(f32x4, snb, r * 32u + 16u); }
                const unsigned oo = r * (unsigned)(QKVP * 2) + co;
#pragma unroll
                for (int bj = 0; bj < 2; ++bj) { f32x4 v0 = acc[ai][bj][m][0] * rs, v1 = acc[ai][bj][m][1] * rs;
                    if (rope) { f32x4 p0, p1;
#pragma unroll
                        for (int k = 0; k < 4; ++k) { p0[k] = __shfl_xor(v0[k], 16); p1[k] = __shfl_xor(v1[k], 16); }
                        v0 = v0 * c0 + (p0 * s0) * sgn; v1 = v1 * c1 + (p1 * s1) * sgn; }
                    v0 = v0 * sc; v1 = v1 * sc;
                    if (knorm) { float q_ = (v0[0] * v0[0] + v0[1] * v0[1]) + (v0[2] * v0[2] + v0[3] * v0[3]) + (v1[0] * v1[0] + v1[1] * v1[1]) + (v1[2] * v1[2] + v1[3] * v1[3]);
                        q_ += __shfl_xor(q_, 16); q_ += __shfl_xor(q_, 32); kx[bj] = fmaxf(kx[bj], q_); }
                    PG8_STORE(pack8(v0, v1), PG8_AT(u32x4, ob, oo + bj * 256u), u.last); }
                if (m & 1) asm volatile("" ::: "memory"); }
        if (knorm) {
#pragma unroll
            for (int bj = 0; bj < 2; ++bj) { float q_ = kx[bj];
#pragma unroll
                for (int o_ = 1; o_ < 16; o_ <<= 1) q_ = fmaxf(q_, __shfl_xor(q_, o_));
                if (fr == 0 && fq == 0) __hip_atomic_fetch_max(kmx + (u.pm >> 5) * 16 + ((u.pn - 8) * 4 + bj * 2 + (wc >> 1)) * 2 + (wc & 1), __float_as_uint(q_ * 1.03f), __ATOMIC_RELAXED, __HIP_MEMORY_SCOPE_AGENT); }
        }
    }
};

template <bool SCATTER> struct EpiRes {
    bf16_t* H; float* ssq; const int* tok; const float* gate; unsigned char* h8; float osc;
    __device__ __forceinline__ RsPend pre_load(const Unit&, int) const { return park_none(); }
    __device__ __forceinline__ void pre_store(const RsPend&, PG8_LAS float*, int) const {}
    __device__ __forceinline__ void operator()(const AccT& acc, const Unit& u, int wr, int wc, int fr, int fq, const PG8_LAS float* rsl) const {
        const unsigned rl = (unsigned)(wr * 64 + fr);
        bf16_t* hb = H + u.pn * BM + (SCATTER ? (size_t)0 : (size_t)u.pm * BM * DM); unsigned char* h8b = h8 + (size_t)u.pm * BM * DM + u.pn * BM;
        float* sb = ssq + (SCATTER ? 0 : u.pm * BM * 16) + u.pn * 4 + wc;
        const int* tb = tok + u.aux; const float* gb = gate + u.aux;
        const unsigned co = (unsigned)(wc * 32 + 8 * fq) * 2u;
#pragma unroll
        for (int ai = 0; ai < 2; ++ai)
#pragma unroll
            for (int m = 0; m < 4; ++m) { const unsigned r = rl + ai * HALF + m * 16;
                int row = (int)r; float gs = osc;
                if (SCATTER) { row = *PG8_ATC(int, tb, r * 4u); gs = *PG8_ATC(float, gb, r * 4u); }
                const bool valid = row >= 0; float ss = 0.f;
                if (valid) { const unsigned ho = (unsigned)row * (unsigned)(DM * 2) + co;
#pragma unroll
                    for (int bj = 0; bj < 2; ++bj) { const u32x4 old = *PG8_ATC(u32x4, hb, ho + bj * 256u); const f32x4 a0 = acc[ai][bj][m][0] * gs, a1 = acc[ai][bj][m][1] * gs;
                        u32x4 w; w.x = cvt_pk(bf_lo(old.x) + a0[0], bf_hi(old.x) + a0[1]); w.y = cvt_pk(bf_lo(old.y) + a0[2], bf_hi(old.y) + a0[3]);
                        w.z = cvt_pk(bf_lo(old.z) + a1[0], bf_hi(old.z) + a1[1]); w.w = cvt_pk(bf_lo(old.w) + a1[2], bf_hi(old.w) + a1[3]);
                        PG8_STORE(w, PG8_AT(u32x4, hb, ho + bj * 256u), u.last);
                        if (h8) *PG8_AT(u32x2, h8b, (unsigned)row * (unsigned)DM + (co >> 1) + bj * 128u) = (u32x2){pk_fp8x4(bf_lo(w.x), bf_hi(w.x), bf_lo(w.y), bf_hi(w.y)), pk_fp8x4(bf_lo(w.z), bf_hi(w.z), bf_lo(w.w), bf_hi(w.w))};
                        ss += bf_lo(w.x) * bf_lo(w.x) + bf_hi(w.x) * bf_hi(w.x) + bf_lo(w.y) * bf_lo(w.y) + bf_hi(w.y) * bf_hi(w.y) + bf_lo(w.z) * bf_lo(w.z) + bf_hi(w.z) * bf_hi(w.z) + bf_lo(w.w) * bf_lo(w.w) + bf_hi(w.w) * bf_hi(w.w); } }
                if (ssq) { ss += __shfl_xor(ss, 16); ss += __shfl_xor(ss, 32); if (fq == 0 && valid) *PG8_AT(float, sb, (unsigned)row * 64u) = ss; }
                if (m & 1) asm volatile("" ::: "memory"); }
    }
};

struct EpiMoeDown {
    bf16_t* H; bf16_t* Y; float* ssq; const int* tok; const float* gate; int pass; float osc;
    __device__ __forceinline__ RsPend pre_load(const Unit&, int) const { return park_none(); }
    __device__ __forceinline__ void pre_store(const RsPend&, PG8_LAS float*, int) const {}
    __device__ __forceinline__ void operator()(const AccT& acc, const Unit& u, int wr, int wc, int fr, int fq, const PG8_LAS float* rsl) const {
        const unsigned rl = (unsigned)(wr * 64 + fr);
        bf16_t* hb = H + u.pn * BM; bf16_t* yb = Y + u.pn * BM;
        const int* tb = tok + u.aux; const float* gb = gate + u.aux;
        const unsigned co = (unsigned)(wc * 32 + 8 * fq) * 2u;
#pragma unroll
        for (int ai = 0; ai < 2; ++ai)
#pragma unroll
            for (int m = 0; m < 4; ++m) { const unsigned r = rl + ai * HALF + m * 16;
                const int row = *PG8_ATC(int, tb, r * 4u); const float gs = *PG8_ATC(float, gb, r * 4u) * osc;
                const bool valid = row >= 0; float ss = 0.f;
                if (valid) { const unsigned ho = (unsigned)row * (unsigned)(DM * 2) + co;
#pragma unroll
                    for (int bj = 0; bj < 2; ++bj) { const f32x4 a0 = acc[ai][bj][m][0] * gs, a1 = acc[ai][bj][m][1] * gs;
                        if (pass == 0) { PG8_STORE(pack8(a0, a1), PG8_AT(u32x4, yb, ho + bj * 256u), u.last); }
                        else { const u32x4 old = *PG8_ATC(u32x4, hb, ho + bj * 256u), y = *PG8_ATC(u32x4, yb, ho + bj * 256u);
                            u32x4 w; w.x = cvt_pk(bf_lo(old.x) + (bf_lo(y.x) + a0[0]), bf_hi(old.x) + (bf_hi(y.x) + a0[1])); w.y = cvt_pk(bf_lo(old.y) + (bf_lo(y.y) + a0[2]), bf_hi(old.y) + (bf_hi(y.y) + a0[3]));
                            w.z = cvt_pk(bf_lo(old.z) + (bf_lo(y.z) + a1[0]), bf_hi(old.z) + (bf_hi(y.z) + a1[1])); w.w = cvt_pk(bf_lo(old.w) + (bf_lo(y.w) + a1[2]), bf_hi(old.w) + (bf_hi(y.w) + a1[3]));
                            PG8_STORE(w, PG8_AT(u32x4, hb, ho + bj * 256u), u.last);
                            ss += bf_lo(w.x) * bf_lo(w.x) + bf_hi(w.x) * bf_hi(w.x) + bf_lo(w.y) * bf_lo(w.y) + bf_hi(w.y) * bf_hi(w.y) + bf_lo(w.z) * bf_lo(w.z) + bf_hi(w.z) * bf_hi(w.z) + bf_lo(w.w) * bf_lo(w.w) + bf_hi(w.w) * bf_hi(w.w); } } }
                if (pass != 0) { ss += __shfl_xor(ss, 16); ss += __shfl_xor(ss, 32); if (fq == 0 && valid) *PG8_AT(float, ssq + u.pn * 4 + wc, (unsigned)row * 64u) = ss; }
                if (m & 1) asm volatile("" ::: "memory"); }
    }
};

template <bool RS, int LDO> struct EpiPlain {
    const float* ssq; float sc;
    __device__ __forceinline__ RsPend pre_load(const Unit& u, int tid) const { return RS ? park_load(ssq, (unsigned)(u.pm * BM + (tid >> 1)), tid) : park_none(); }
    __device__ __forceinline__ void pre_store(const RsPend& r, PG8_LAS float* rs, int tid) const { if (RS) park_store(r, rs, tid); }
    __device__ __forceinline__ void operator()(const AccT& acc, const Unit& u, int wr, int wc, int fr, int fq, const PG8_LAS float* rsl) const {
        const unsigned rl = (unsigned)(wr * 64 + fr); const float* ssqb = ssq + (RS ? u.pm * BM * 16 : 0);
        const unsigned co = (unsigned)(wc * 32 + 8 * fq) * 2u;
#pragma unroll
        for (int ai = 0; ai < 2; ++ai)
#pragma unroll
            for (int m = 0; m < 4; ++m) { const unsigned r = rl + ai * HALF + m * 16; float rs = sc; if (RS) rs *= rsl[r];
                const unsigned oo = r * (unsigned)((LDO ? LDO : u.aux) * 2) + co;
#pragma unroll
                for (int bj = 0; bj < 2; ++bj) *PG8_AT(u32x4, u.o, oo + bj * 256u) = pack8(acc[ai][bj][m][0] * rs, acc[ai][bj][m][1] * rs);
                if (m & 1) asm volatile("" ::: "memory"); }
    }
};

template <int LDO> struct EpiPlain8 {
    float sc;
    __device__ __forceinline__ RsPend pre_load(const Unit&, int) const { return park_none(); }
    __device__ __forceinline__ void pre_store(const RsPend&, PG8_LAS float*, int) const {}
    __device__ __forceinline__ void operator()(const AccT& acc, const Unit& u, int wr, int wc, int fr, int fq, const PG8_LAS float* rsl) const {
        const unsigned rl = (unsigned)(wr * 64 + fr);
        const unsigned co = (unsigned)(wc * 32 + 8 * fq);
#pragma unroll
        for (int ai = 0; ai < 2; ++ai)
#pragma unroll
            for (int m = 0; m < 4; ++m) { const unsigned r = rl + ai * HALF + m * 16; const unsigned oo = r * (unsigned)LDO + co;
#pragma unroll
                for (int bj = 0; bj < 2; ++bj) { const f32x4 a0 = acc[ai][bj][m][0] * sc, a1 = acc[ai][bj][m][1] * sc;
                    *PG8_AT(u32x2, u.o, oo + bj * 128u) = (u32x2){pk_fp8x4(a0[0], a0[1], a0[2], a0[3]), pk_fp8x4(a1[0], a1[1], a1[2], a1[3])}; }
                if (m & 1) asm volatile("" ::: "memory"); }
    }
};

template <bool MOE, int LDU> struct EpiSwiglu8 {
    unsigned char* U; const float* ssq; const int* tok;
    __device__ __forceinline__ RsPend pre_load(const Unit& u, int tid) const { int row = u.aux + (tid >> 1); if (MOE) { row = tok[row]; row = row < 0 ? 0 : row; } return park_load(ssq, (unsigned)row, tid); }
    __device__ __forceinline__ void pre_store(const RsPend& r, PG8_LAS float* rs, int tid) const { park_store(r, rs, tid); }
    __device__ __forceinline__ void operator()(const AccT& acc, const Unit& u, int wr, int wc, int fr, int fq, const PG8_LAS float* rsl) const {
        const unsigned rl = (unsigned)(wr * 64 + fr);
        unsigned char* ub = U + (size_t)u.aux * LDU + u.pn * HALF;
        const unsigned co = (unsigned)(wc * 32 + 8 * fq);
#pragma unroll
        for (int ai = 0; ai < 2; ++ai)
#pragma unroll
            for (int m = 0; m < 4; ++m) { const unsigned r = rl + ai * HALF + m * 16;
                const float rs = rsl[r] * (1.f / F8_W1), c2 = -LOG2E * rs, c3 = rs * rs * F8_U;
                f32x4 o[2];
#pragma unroll
                for (int n = 0; n < 2; ++n) { const f32x4 a = acc[ai][0][m][n], b = acc[ai][1][m][n]; const f32x4 t = a * c2; f32x4 e, rr;
#pragma unroll
                    for (int k = 0; k < 4; ++k) e[k] = __builtin_amdgcn_exp2f(t[k]);
                    const f32x4 d = e + 1.f;
#pragma unroll
                    for (int k = 0; k < 4; ++k) rr[k] = __builtin_amdgcn_rcpf(d[k]);
                    o[n] = ((a * b) * c3) * rr; }
                PG8_STORE((u32x2){pk_fp8x4(o[0][0], o[0][1], o[0][2], o[0][3]), pk_fp8x4(o[1][0], o[1][1], o[1][2], o[1][3])}, PG8_AT(u32x2, ub, r * (unsigned)LDU + co), u.last);
                if (m & 1) asm volatile("" ::: "memory"); }
    }
};

template <bool MOE, int LDU> struct EpiSwiglu {
    bf16_t* U; const float* ssq; const int* tok;
    __device__ __forceinline__ RsPend pre_load(const Unit& u, int tid) const { int row = u.aux + (tid >> 1); if (MOE) { row = tok[row]; row = row < 0 ? 0 : row; } return park_load(ssq, (unsigned)row, tid); }
    __device__ __forceinline__ void pre_store(const RsPend& r, PG8_LAS float* rs, int tid) const { park_store(r, rs, tid); }
    __device__ __forceinline__ void operator()(const AccT& acc, const Unit& u, int wr, int wc, int fr, int fq, const PG8_LAS float* rsl) const {
        const unsigned rl = (unsigned)(wr * 64 + fr);
        bf16_t* ub = U + (size_t)u.aux * LDU + u.pn * HALF; const int* tb = tok + u.aux; const float* sb = ssq + (MOE ? 0 : u.aux * 16);
        const unsigned co = (unsigned)(wc * 32 + 8 * fq) * 2u;
#pragma unroll
        for (int ai = 0; ai < 2; ++ai)
#pragma unroll
            for (int m = 0; m < 4; ++m) { const unsigned r = rl + ai * HALF + m * 16;
                const float rs = rsl[r], c2 = -LOG2E * rs, c3 = rs * rs;
                f32x4 o[2];
#pragma unroll
                for (int n = 0; n < 2; ++n) { const f32x4 a = acc[ai][0][m][n], b = acc[ai][1][m][n]; const f32x4 t = a * c2; f32x4 e, rr;
#pragma unroll
                    for (int k = 0; k < 4; ++k) e[k] = __builtin_amdgcn_exp2f(t[k]);
                    const f32x4 d = e + 1.f;
#pragma unroll
                    for (int k = 0; k < 4; ++k) rr[k] = __builtin_amdgcn_rcpf(d[k]);
                    o[n] = ((a * b) * c3) * rr; }
                PG8_STORE(pack8(o[0], o[1]), PG8_AT(u32x4, ub, r * (unsigned)(LDU * 2) + co), u.last);
                if (m & 1) asm volatile("" ::: "memory"); }
    }
};

__device__ __forceinline__ float quad_max(float v) { auto a = __builtin_amdgcn_permlane16_swap(__float_as_uint(v), __float_as_uint(v), false, false); v = fmaxf(__uint_as_float(a[0]), __uint_as_float(a[1]));
    auto b = __builtin_amdgcn_permlane32_swap(__float_as_uint(v), __float_as_uint(v), false, false); return fmaxf(__uint_as_float(b[0]), __uint_as_float(b[1])); }
__device__ __forceinline__ float quad_sum(float v) { auto a = __builtin_amdgcn_permlane16_swap(__float_as_uint(v), __float_as_uint(v), false, false); v = __uint_as_float(a[0]) + __uint_as_float(a[1]);
    auto b = __builtin_amdgcn_permlane32_swap(__float_as_uint(v), __float_as_uint(v), false, false); return __uint_as_float(b[0]) + __uint_as_float(b[1]); }
template <bool P8> struct EpiSoftmax {
    static constexpr bool LATE_RS = true;
    PG8_LAS float* X; const float* ssq; float sc;
    __device__ __forceinline__ RsPend pre_load(const Unit& u, int tid) const { return park_load(ssq, (unsigned)(u.pm * BM + (tid >> 1)), tid); }
    __device__ __forceinline__ void pre_store(const RsPend& r, PG8_LAS float* rs, int tid) const { park_store(r, rs, tid); }
    __device__ __forceinline__ void operator()(AccT& acc, const Unit& u, int wr, int wc, int fr, int fq, const PG8_LAS float* rsl) const {
        const int rl = wr * 64 + fr;
#pragma unroll
        for (int ai = 0; ai < 2; ++ai)
#pragma unroll
            for (int m = 0; m < 4; ++m) { float v = -INFINITY; const float rs_ = rsl[rl + ai * HALF + m * 16] * sc;
#pragma unroll
                for (int bj = 0; bj < 2; ++bj)
#pragma unroll
                    for (int n = 0; n < 2; ++n) { const f32x4 x = acc[ai][bj][m][n] * rs_; acc[ai][bj][m][n] = x; v = fmaxf(v, fmaxf(fmaxf(x[0], x[1]), fmaxf(x[2], x[3]))); }
                v = quad_max(v);
                if (fq == 0) X[(rl + ai * HALF + m * 16) * 4 + wc] = v; asm volatile("" ::: "memory"); }
        asm volatile("s_waitcnt lgkmcnt(0)" ::: "memory"); __builtin_amdgcn_s_barrier(); asm volatile("" ::: "memory");
        int rl2 = rl; asm volatile("" : "+v"(rl2));
#pragma unroll
        for (int ai = 0; ai < 2; ++ai)
#pragma unroll
            for (int m = 0; m < 4; ++m) { const int r = rl2 + ai * HALF + m * 16; const f32x4 q = *(const PG8_LAS f32x4*)(X + r * 4);
                const float M = fmaxf(fmaxf(q[0], q[1]), fmaxf(q[2], q[3])); float s = 0.f;
#pragma unroll
                for (int bj = 0; bj < 2; ++bj)
#pragma unroll
                    for (int n = 0; n < 2; ++n) { f32x4 e;
#pragma unroll
                        for (int k = 0; k < 4; ++k) { e[k] = __builtin_amdgcn_exp2f(acc[ai][bj][m][n][k] - M); s += e[k]; }
                        acc[ai][bj][m][n] = e; }
                s = quad_sum(s);
                if (fq == 0) X[1024 + r * 4 + wc] = s; asm volatile("" ::: "memory"); }
        asm volatile("s_waitcnt lgkmcnt(0)" ::: "memory"); __builtin_amdgcn_s_barrier(); asm volatile("" ::: "memory");
        const unsigned co = (unsigned)(wc * 32 + 8 * fq) * 2u;
        int rl3 = rl; asm volatile("" : "+v"(rl3));
#pragma unroll
        for (int ai = 0; ai < 2; ++ai)
#pragma unroll
            for (int m = 0; m < 4; ++m) { const int r = rl3 + ai * HALF + m * 16; const f32x4 q = *(const PG8_LAS f32x4*)(X + 1024 + r * 4);
                const float inv = __builtin_amdgcn_rcpf((q[0] + q[1]) + (q[2] + q[3])) * (P8 ? F8_P : 1.f);
                const unsigned oo = P8 ? (unsigned)r * (unsigned)DM + (co >> 1) : (unsigned)r * (unsigned)(DM * 2) + co;
#pragma unroll
                for (int bj = 0; bj < 2; ++bj) { const f32x4 a0 = acc[ai][bj][m][0] * inv, a1 = acc[ai][bj][m][1] * inv;
                    if constexpr (P8) PG8_STORE((u32x2){pk_fp8x4(a0[0], a0[1], a0[2], a0[3]), pk_fp8x4(a1[0], a1[1], a1[2], a1[3])}, PG8_AT(u32x2, u.o, oo + bj * 128u), u.last);
                    else PG8_STORE(pack8(a0, a1), PG8_AT(u32x4, u.o, oo + bj * 256u), u.last); }
                if (m & 1) asm volatile("" ::: "memory"); }
    }
};

struct EpiRouter {
    const float* ssq; int* choice; float* gates; int* cnt; PG8_LAS int* hist;
    __device__ __forceinline__ RsPend pre_load(const Unit& u, int tid) const { return park_load(ssq, (unsigned)(u.pm * BM + (tid >> 1)), tid); }
    __device__ __forceinline__ void pre_store(const RsPend& r, PG8_LAS float* rs, int tid) const { park_store(r, rs, tid); }
    __device__ __forceinline__ void operator()(const AccT& acc, const Unit& u, int wr, int wc, int fr, int fq, const PG8_LAS float* rsl) const {
        if (wc == 0 && fq == 0) {
            const float* ssqb = ssq + u.pm * BM * 16; int* chb = choice + u.pm * BM; float* gb = gates + u.pm * BM * 2;
#pragma unroll
            for (int ai = 0; ai < 2; ++ai)
#pragma unroll
                for (int m = 0; m < 4; ++m) { const unsigned r = (unsigned)(ai * HALF + wr * 64 + m * 16 + fr); const float rs = rsl[r];
                    float x[8];
#pragma unroll
                    for (int k = 0; k < 4; ++k) { x[k] = acc[ai][0][m][0][k] * rs; x[4 + k] = acc[ai][0][m][1][k] * rs; }
                    int e0 = 0; float v0 = x[0];
#pragma unroll
                    for (int k = 1; k < 8; ++k) if (x[k] > v0) { v0 = x[k]; e0 = k; }
                    int e1 = 0; float v1 = -INFINITY;
#pragma unroll
                    for (int k = 0; k < 8; ++k) if (k != e0 && x[k] > v1) { v1 = x[k]; e1 = k; }
                    if (!(v1 > -INFINITY)) e1 = (e0 + 1) & 7;
                    const float g1 = 1.f / (1.f + __expf(v0 - v1)), g0 = 1.f - g1;
                    *PG8_AT(int, chb, r * 4u) = e0 | (e1 << 8); *PG8_AT(f32x2, gb, r * 8u) = (f32x2){g0, g1};
                    __hip_atomic_fetch_add(hist + e0, 1, __ATOMIC_RELAXED, __HIP_MEMORY_SCOPE_WORKGROUP); __hip_atomic_fetch_add(hist + 8 + e1, 1, __ATOMIC_RELAXED, __HIP_MEMORY_SCOPE_WORKGROUP); }
        }
        asm volatile("s_waitcnt lgkmcnt(0)" ::: "memory"); __builtin_amdgcn_s_barrier(); asm volatile("" ::: "memory");
        { int t_ = wr * 256 + wc * 64 + fq * 16 + fr; if (t_ < 16) { cnt[u.pm * 16 + t_] = hist[t_]; hist[t_] = 0; } }
        asm volatile("s_waitcnt lgkmcnt(0)" ::: "memory"); __builtin_amdgcn_s_barrier(); asm volatile("" ::: "memory");
    }
};

struct SchedDense {
    const char* A; const char* B; char* O; size_t a_tile, b_tile, o_tile; int nM, nN, G, c;
    __device__ __forceinline__ bool next(int i, Unit& u) const {
        if (!tile_order(i, G, c, nM, nN, u.pm, u.pn)) return false;
        u.a = A + (size_t)u.pm * a_tile; u.b = B + (size_t)u.pn * b_tile; u.o = O ? O + (size_t)u.pm * o_tile + (size_t)u.pn * 512 : nullptr; u.aux = u.pm * BM; u.ridx = nullptr; return true; }
};
}

namespace attn_body {
using bf16 = __hip_bfloat16;
using bf16x8 = __attribute__((ext_vector_type(8))) short;
using s16x4 = __attribute__((ext_vector_type(4))) short;
using f32x16 = __attribute__((ext_vector_type(16))) float;
using f32x4 = __attribute__((ext_vector_type(4))) float;
using u32x4 = __attribute__((ext_vector_type(4))) unsigned;
constexpr int D = 64, PQ = QKVP;
constexpr int NW = 8, QBLK = 32, QB = QBLK * NW, KVBLK = 64, NQB = SEQ / QB;
__device__ __forceinline__ int crow(int r, int hi) { return (r & 3) + 8 * (r >> 2) + 4 * hi; }
#define SBAR() __builtin_amdgcn_sched_barrier(0)
__device__ __forceinline__ void cmask(f32x16& p0, f32x16& p1, int jb, int qrel, int hi) {
  const float NEG = -INFINITY; int kb = 64 * jb + 4 * hi;
  #pragma unroll
  for (int r = 0; r < 16; ++r) { int kv = kb + (r & 3) + 8 * (r >> 2); if (kv > qrel) p0[r] = NEG; if (kv + 32 > qrel) p1[r] = NEG; }
}
constexpr int NSLOT = 3, SLOTB = 8192;
constexpr int LDS_K = 0, LDS_V = NSLOT * SLOTB, LDS_WS = 2 * NSLOT * SLOTB, LDS_OST = LDS_WS + NW * 64 * 4, LDS_TAB = LDS_OST + NW * 4096, LDS_BYTES = LDS_TAB + SEQ * 4;
__device__ __forceinline__ void glds16(const void* gsrc, unsigned lds_dst) { unsigned keep;
  asm volatile("s_mov_b32 %0, m0\n\ts_mov_b32 m0, %2\n\ts_nop 0\n\tglobal_load_lds_dwordx4 %1, off\n\ts_mov_b32 m0, %0" : "=&s"(keep) : "v"(gsrc), "s"(lds_dst) : "memory"); }
__device__ __forceinline__ float max3f(float a, float b, float c) { float r; asm("v_max3_f32 %0, %1, %2, %3" : "=v"(r) : "v"(a), "v"(b), "v"(c)); return r; }
__device__ __forceinline__ float max2f(float a, float b) { float r; asm("v_max_f32_e32 %0, %1, %2" : "=v"(r) : "v"(a), "v"(b)); return r; }
__device__ __forceinline__ float fadd_s(float a, float b) { float r; asm("v_add_f32_e32 %0, %1, %2" : "=v"(r) : "v"(a), "v"(b)); return r; }
__device__ __forceinline__ float fsub_s(float a, float b) { float r; asm("v_sub_f32_e32 %0, %1, %2" : "=v"(r) : "v"(a), "v"(b)); return r; }
typedef float f32x2_t __attribute__((ext_vector_type(2))); typedef __bf16 bf16x2_t __attribute__((ext_vector_type(2)));
__device__ __forceinline__ unsigned cvtpk_s(float lo, float hi) { f32x2_t v = {lo, hi}; bf16x2_t b = __builtin_convertvector(v, bf16x2_t); return __builtin_bit_cast(unsigned, b); }
#define WAIT_BAR(N) asm volatile("s_waitcnt vmcnt(" #N ") lgkmcnt(0)\n\ts_barrier" ::: "memory")

__device__ __forceinline__ void qkt(f32x16& p0, f32x16& p1, const char* Kslot, const bf16x8* qr, const f32x16& c0, const f32x16& c1, int r32, int hi) {
  const char* kb = Kslot + hi * 1024 + r32 * 16;
  #pragma unroll
  for (int d0 = 0; d0 < 4; ++d0) {
    const bf16x8 b0 = *reinterpret_cast<const bf16x8*>(kb + d0 * 2048);
    const bf16x8 b1 = *reinterpret_cast<const bf16x8*>(kb + d0 * 2048 + 512);
    if (d0 == 0) { p0 = __builtin_amdgcn_mfma_f32_32x32x16_bf16(b0, qr[0], c0, 0, 0, 0); p1 = __builtin_amdgcn_mfma_f32_32x32x16_bf16(b1, qr[0], c1, 0, 0, 0); }
    else { p0 = __builtin_amdgcn_mfma_f32_32x32x16_bf16(b0, qr[d0], p0, 0, 0, 0); p1 = __builtin_amdgcn_mfma_f32_32x32x16_bf16(b1, qr[d0], p1, 0, 0, 0); } }
}
typedef __attribute__((address_space(3))) const char* lds_cptr;
typedef short v4i16_t __attribute__((ext_vector_type(4)));
__device__ __forceinline__ void kload8(bf16x8* kf, lds_cptr kp) {
  kf[0] = *(const __attribute__((address_space(3))) bf16x8*)(kp);        kf[1] = *(const __attribute__((address_space(3))) bf16x8*)(kp + 512);
  kf[2] = *(const __attribute__((address_space(3))) bf16x8*)(kp + 2048); kf[3] = *(const __attribute__((address_space(3))) bf16x8*)(kp + 2560);
  kf[4] = *(const __attribute__((address_space(3))) bf16x8*)(kp + 4096); kf[5] = *(const __attribute__((address_space(3))) bf16x8*)(kp + 4608);
  kf[6] = *(const __attribute__((address_space(3))) bf16x8*)(kp + 6144); kf[7] = *(const __attribute__((address_space(3))) bf16x8*)(kp + 6656);
}
__device__ __forceinline__ void kload2(bf16x8* kf, lds_cptr kp, int j) { kf[2 * j] = *(const __attribute__((address_space(3))) bf16x8*)(kp + j * 2048); kf[2 * j + 1] = *(const __attribute__((address_space(3))) bf16x8*)(kp + j * 2048 + 512); }
__device__ __forceinline__ s16x4 vtr(lds_cptr p) { return __builtin_bit_cast(s16x4, __builtin_amdgcn_ds_read_tr16_b64_v4i16((__attribute__((address_space(3))) v4i16_t*)p)); }
__device__ __forceinline__ float rowmax(const f32x16& p0, const f32x16& p1) {
  float a = max3f(p0[0], p0[1], p1[0]), b = max3f(p0[2], p0[3], p1[1]); a = max3f(a, p1[2], p1[3]);
  #pragma unroll
  for (int r = 4; r < 16; r += 4) { a = max3f(a, p0[r], p0[r + 1]); b = max3f(b, p0[r + 2], p0[r + 3]); a = max3f(a, p1[r], p1[r + 1]); b = max3f(b, p1[r + 2], p1[r + 3]); }
  const float m = max2f(a, b);
  auto rr = __builtin_amdgcn_permlane32_swap(__float_as_uint(m), __float_as_uint(m), false, false);
  return max2f(__uint_as_float(rr[0]), __uint_as_float(rr[1]));
}
__device__ __forceinline__ void pv(f32x16* o, int vb, bf16x8 pa0, bf16x8 pa1, bf16x8 pa2, bf16x8 pa3) {
  #pragma unroll
  for (int d0 = 0; d0 < 2; ++d0) { s16x4 lo[4], hi[4];
    #pragma unroll
    for (int ks = 0; ks < 4; ++ks) {
      asm volatile("ds_read_b64_tr_b16 %0,%1 offset:%c2" : "=&v"(lo[ks]) : "v"(vb), "i"(d0 * 4096 + ks * 1024) : "memory");
      asm volatile("ds_read_b64_tr_b16 %0,%1 offset:%c2" : "=&v"(hi[ks]) : "v"(vb), "i"(d0 * 4096 + ks * 1024 + 512) : "memory"); }
    asm volatile("s_waitcnt lgkmcnt(0)" ::: "memory"); SBAR();
    #define PK(k) (bf16x8){lo[k][0], lo[k][1], lo[k][2], lo[k][3], hi[k][0], hi[k][1], hi[k][2], hi[k][3]}
    o[d0] = __builtin_amdgcn_mfma_f32_32x32x16_bf16(pa0, PK(0), o[d0], 0, 0, 0);
    o[d0] = __builtin_amdgcn_mfma_f32_32x32x16_bf16(pa1, PK(1), o[d0], 0, 0, 0);
    o[d0] = __builtin_amdgcn_mfma_f32_32x32x16_bf16(pa2, PK(2), o[d0], 0, 0, 0);
    o[d0] = __builtin_amdgcn_mfma_f32_32x32x16_bf16(pa3, PK(3), o[d0], 0, 0, 0);
    #undef PK
  }
}

template <int THRL> __device__ __forceinline__ void fox_unit(int qb, const bf16* Q, const bf16* __restrict__ K, const bf16* __restrict__ V, bf16* O, int po, const float* biasg, float kmaxn, char* shm) {
  constexpr bool BIAS = true;
  int tid_ = threadIdx.x; asm volatile("" : "+v"(tid_));
  const int tid = tid_, lane = tid & 63, r32 = lane & 31, hi = lane >> 5; const int wid = __builtin_amdgcn_readfirstlane(tid >> 6);
  const int q0 = qb * QB;
  const bf16* Qw = Q + (long)(q0 + wid * QBLK) * PQ;
  const unsigned lds0 = (unsigned)(uintptr_t)shm;
  float* wsf = (float*)(shm + LDS_WS) + wid * 64;
  const int NT = (q0 + QB) / KVBLK;
  #define TILE(u) (NT - 1 - (u))
  const __attribute__((address_space(3))) f32x4* tab4 = (const __attribute__((address_space(3))) f32x4*)((lds_cptr)shm + LDS_TAB);
  const bf16* ksrc = K + (long)lane * PQ + wid * 8;
  const bf16* vsrc = V + (long)(16 * (wid & 3) + (lane >> 2)) * PQ + (wid >> 2) * 32 + (lane & 3) * 8;
  const unsigned kdst = lds0 + LDS_K + wid * 1024, vdst = lds0 + LDS_V + wid * 1024;
  #define DMA_K(t, slot) glds16(ksrc + (long)TILE(t) * KVBLK * PQ, (unsigned)__builtin_amdgcn_readfirstlane(kdst + (slot)))
  #define DMA_V(t, slot) glds16(vsrc + (long)TILE(t) * KVBLK * PQ, (unsigned)__builtin_amdgcn_readfirstlane(vdst + (slot)))
  const int vb0 = (int)(lds0 + LDS_V) + ((lane >> 4) & 1) * 32 + (lane & 3) * 8 + (4 * hi + ((lane & 15) >> 2)) * 64;
  const char* Kbase = shm + LDS_K; bf16x8 kf[8];
  const lds_cptr shm3 = (lds_cptr)shm; const lds_cptr kp0 = shm3 + LDS_K + hi * 1024 + r32 * 16; const lds_cptr vp0 = shm3 + LDS_V + ((lane >> 4) & 1) * 32 + (lane & 3) * 8 + (4 * hi + ((lane & 15) >> 2)) * 64;
  DMA_K(0, 0); DMA_V(0, 0); DMA_K(1, SLOTB);
  {
    __attribute__((address_space(3))) f32x4* tw = (__attribute__((address_space(3))) f32x4*)((__attribute__((address_space(3))) char*)shm + LDS_TAB);
    for (int i = tid; i < NT * 16; i += NW * 64) tw[i] = *(const __attribute__((address_space(1))) f32x4*)(const void*)(biasg + 4 * i);
  }
  bf16x8 qr[4];
  #pragma unroll
  for (int d0 = 0; d0 < 4; ++d0) qr[d0] = *reinterpret_cast<const bf16x8*>(&Qw[(long)r32 * PQ + d0 * 16 + hi * 8]);
  float mhat = 0.f, l_reg = 0.f; f32x16 o[2]; o[0] = f32x16{}; o[1] = f32x16{}; f32x16 negm = f32x16{}; asm volatile("" : "+v"(negm));
  const int qrel = wid * QBLK + r32;
  #define CMASK(P0, P1, t) do { int jb_ = 3 - (t); if (jb_ >= 0) cmask(P0, P1, jb_, qrel, hi); } while (0)
  #define BIASFILL(C0, C1, t) do { const __attribute__((address_space(3))) f32x4* tp_ = tab4 + TILE(t) * 16 + hi; \
      _Pragma("unroll") for (int j_ = 0; j_ < 4; ++j_) { const f32x4 a_ = tp_[2 * j_], b_ = tp_[8 + 2 * j_]; \
        C0[4 * j_] = a_[0] - mhat; C0[4 * j_ + 1] = a_[1] - mhat; C0[4 * j_ + 2] = a_[2] - mhat; C0[4 * j_ + 3] = a_[3] - mhat; \
        C1[4 * j_] = b_[0] - mhat; C1[4 * j_ + 1] = b_[1] - mhat; C1[4 * j_ + 2] = b_[2] - mhat; C1[4 * j_ + 3] = b_[3] - mhat; } } while (0)
  bool resc = false;
  #define START(P0, P1) do { const float rm = rowmax(P0, P1); resc = false; \
    { const float dl = max2f(rm, -1.0e4f); mhat = fadd_s(mhat, dl);     \
      _Pragma("unroll") for (int r = 0; r < 16; ++r) { P0[r] = fsub_s(P0[r], dl); P1[r] = fsub_s(P1[r], dl); } \
      if (!BIAS) { _Pragma("unroll") for (int r = 0; r < 16; ++r) negm[r] = -mhat; asm volatile("" : "+v"(negm)); } } \
    _Pragma("unroll") for (int r = 0; r < 16; ++r) P0[r] = __builtin_amdgcn_exp2f(P0[r]); } while (0)
  #define RESC() do { if (resc) { asm volatile("s_waitcnt lgkmcnt(0)" ::: "memory"); \
      _Pragma("unroll") for (int d_ = 0; d_ < 2; ++d_) _Pragma("unroll") for (int r = 0; r < 16; ++r) o[d_][r] *= wsf[crow(r, hi)]; } } while (0)
  f32x16 pA0, pA1, pB0, pB1;
  int sl_prev = 0, sl_cur = 0, sl_next = SLOTB;
  #define ROT() do { sl_prev = sl_cur; sl_cur = sl_next; sl_next = (sl_next == (NSLOT - 1) * SLOTB) ? 0 : sl_next + SLOTB; } while (0)
  DMA_K(2, 2 * SLOTB);
  WAIT_BAR(3);
  if (BIAS) { f32x16 c0, c1; BIASFILL(c0, c1, 0); qkt(pA0, pA1, Kbase, qr, c0, c1, r32, hi); }
  else qkt(pA0, pA1, Kbase, qr, negm, negm, r32, hi);
  asm volatile("s_nop 15\n\ts_nop 7" : "+v"(pA0), "+v"(pA1)); CMASK(pA0, pA1, 0);
  START(pA0, pA1);
  _Pragma("unroll") for (int r = 0; r < 16; ++r) pA1[r] = __builtin_amdgcn_exp2f(pA1[r]);
  WAIT_BAR(0);
  DMA_K(3, 0); DMA_V(1, SLOTB);
  ROT();
  kload8(kf, kp0 + sl_cur);
  WAIT_BAR(2);
  s16x4 vlo[8], vhi[8]; u32x4 pw0, pw1, pw2, pw3;
  #define PKW(P, B) cvtpk_s(P[B], P[B + 1])
  #define PAF(k) __builtin_bit_cast(bf16x8, pw##k)
  #define VFR(i) (bf16x8){vlo[i][0], vlo[i][1], vlo[i][2], vlo[i][3], vhi[i][0], vhi[i][1], vhi[i][2], vhi[i][3]}
  #define PIN(x) asm volatile("" : "+v"(x))
  #define MX3(a, b, c) __builtin_fmaxf(__builtin_fmaxf((a), (b)), (c))
  #define GAPA(MF, A0, A1, A2, A3, W0, W1, PW) do { MF; sacc += A0; sacc += A1; sacc += A2; sacc += A3; PIN(sacc); W0; W1; PIN(PW); SBAR(); } while (0)
  #define EX(v) __builtin_amdgcn_exp2f(v)
  #define GAPB(MF, X, B) do { MF; X[B] = EX(X[B]); X[B + 1] = EX(X[B + 1]); X[B + 2] = EX(X[B + 2]); X[B + 3] = EX(X[B + 3]); PIN(X); SBAR(); } while (0)
  #define VRD(i) do { vlo[i] = vtr(vp_ + (((i) >> 2) * 4096 + ((i) & 3) * 1024)); vhi[i] = vtr(vp_ + (((i) >> 2) * 4096 + ((i) & 3) * 1024 + 512)); } while (0)
  #define KRD(G, j) do { if (G) { kload2(kf, kp0 + sl_next, j); SBAR(); } } while (0)
  #define CI0(C0) (BIAS ? C0 : negm)
  #define STEP(C0, C1, P0, P1, t, GK, GV, GL) do { SBAR(); \
    if (BIAS) { BIASFILL(C0, C1, t); SBAR(); } \
    const lds_cptr vp_ = vp0 + sl_prev; \
    VRD(0); SBAR(); float sacc = (P0[0] + P0[1]); \
    GAPA(C0 = __builtin_amdgcn_mfma_f32_32x32x16_bf16(kf[0], qr[0], CI0(C0), 0, 0, 0), P0[2], P0[3], P0[4], P0[5],     pw0[0] = PKW(P0, 0), pw0[1] = PKW(P0, 2), pw0); \
    VRD(4); SBAR(); GAPA(C1 = __builtin_amdgcn_mfma_f32_32x32x16_bf16(kf[1], qr[0], CI0(C1), 0, 0, 0), P0[6], P0[7], P0[8], P0[9],     pw0[2] = PKW(P0, 4), pw0[3] = PKW(P0, 6), pw0); \
    VRD(1); SBAR(); GAPA(C0 = __builtin_amdgcn_mfma_f32_32x32x16_bf16(kf[2], qr[1], C0, 0, 0, 0),   P0[10], P0[11], P0[12], P0[13], pw1[0] = PKW(P0, 8), pw1[1] = PKW(P0, 10), pw1); \
    VRD(5); SBAR(); GAPA(C1 = __builtin_amdgcn_mfma_f32_32x32x16_bf16(kf[3], qr[1], C1, 0, 0, 0),   P0[14], P0[15], P1[0], P1[1],   pw1[2] = PKW(P0, 12), pw1[3] = PKW(P0, 14), pw1); \
    VRD(2); SBAR(); GAPA(C0 = __builtin_amdgcn_mfma_f32_32x32x16_bf16(kf[4], qr[2], C0, 0, 0, 0),   P1[2], P1[3], P1[4], P1[5],     pw2[0] = PKW(P1, 0), pw2[1] = PKW(P1, 2), pw2); \
    VRD(6); SBAR(); GAPA(C1 = __builtin_amdgcn_mfma_f32_32x32x16_bf16(kf[5], qr[2], C1, 0, 0, 0),   P1[6], P1[7], P1[8], P1[9],     pw2[2] = PKW(P1, 4), pw2[3] = PKW(P1, 6), pw2); \
    VRD(3); SBAR(); GAPA(C0 = __builtin_amdgcn_mfma_f32_32x32x16_bf16(kf[6], qr[3], C0, 0, 0, 0),   P1[10], P1[11], P1[12], P1[13], pw3[0] = PKW(P1, 8), pw3[1] = PKW(P1, 10), pw3); \
    VRD(7); SBAR(); GAPA(C1 = __builtin_amdgcn_mfma_f32_32x32x16_bf16(kf[7], qr[3], C1, 0, 0, 0),   P1[14], P1[15], 0.f, 0.f,       pw3[2] = PKW(P1, 12), pw3[3] = PKW(P1, 14), pw3); \
    l_reg += sacc; \
    if (GK) { DMA_K((t) + 3, sl_cur); } if (GV) { DMA_V((t) + 1, sl_next); } \
    CMASK(C0, C1, t); \
    { float a = MX3(C0[0], C0[1], C1[0]), b = MX3(C0[2], C0[3], C1[1]); a = MX3(a, C1[2], C1[3]); \
      _Pragma("unroll") for (int r = 4; r < 16; r += 4) { a = MX3(a, C0[r], C0[r + 1]); b = MX3(b, C0[r + 2], C0[r + 3]); a = MX3(a, C1[r], C1[r + 1]); b = MX3(b, C1[r + 2], C1[r + 3]); } \
      float rm = __builtin_fmaxf(a, b); { auto rr = __builtin_amdgcn_permlane32_swap(__float_as_uint(rm), __float_as_uint(rm), false, false); rm = __builtin_fmaxf(__uint_as_float(rr[0]), __uint_as_float(rr[1])); } \
      resc = false; \
      if (__builtin_expect(__any(rm > (float)THRL), 0)) { const float dl = __builtin_fmaxf(rm, 0.f); mhat += dl; \
        _Pragma("unroll") for (int r = 0; r < 16; ++r) { C0[r] -= dl; C1[r] -= dl; } \
        if (!BIAS) { _Pragma("unroll") for (int r = 0; r < 16; ++r) negm[r] = -mhat; asm volatile("" : "+v"(negm)); } \
        const float f = __builtin_amdgcn_exp2f(-dl); l_reg *= f; if (hi == 0) wsf[r32] = f; resc = true; } } \
    SBAR(); \
    GAPB(o[0] = __builtin_amdgcn_mfma_f32_32x32x16_bf16(PAF(0), VFR(0), o[0], 0, 0, 0), C0, 0); \
    GAPB(o[1] = __builtin_amdgcn_mfma_f32_32x32x16_bf16(PAF(0), VFR(4), o[1], 0, 0, 0), C0, 4); \
    KRD(GL, 0); GAPB(o[0] = __builtin_amdgcn_mfma_f32_32x32x16_bf16(PAF(1), VFR(1), o[0], 0, 0, 0), C0, 8); \
    KRD(GL, 1); GAPB(o[1] = __builtin_amdgcn_mfma_f32_32x32x16_bf16(PAF(1), VFR(5), o[1], 0, 0, 0), C0, 12); \
    KRD(GL, 2); GAPB(o[0] = __builtin_amdgcn_mfma_f32_32x32x16_bf16(PAF(2), VFR(2), o[0], 0, 0, 0), C1, 0); \
    KRD(GL, 3); GAPB(o[1] = __builtin_amdgcn_mfma_f32_32x32x16_bf16(PAF(2), VFR(6), o[1], 0, 0, 0), C1, 4); \
    GAPB(o[0] = __builtin_amdgcn_mfma_f32_32x32x16_bf16(PAF(3), VFR(3), o[0], 0, 0, 0), C1, 8); \
    GAPB(o[1] = __builtin_amdgcn_mfma_f32_32x32x16_bf16(PAF(3), VFR(7), o[1], 0, 0, 0), C1, 12); \
    } while (0)
  int NE = NT;
  #define ENDW(tt) do { if ((tt) + 3 < NE) { WAIT_BAR(2); } else if ((tt) + 2 < NE) { WAIT_BAR(1); } else { WAIT_BAR(0); } } while (0)
  int t = 1;
  for (; t + 1 < NE; t += 2) {
    if (t == 5 && NT > 8) {
      float qn2 = 0.f;
      #pragma unroll
      for (int d0 = 0; d0 < 4; ++d0)
        #pragma unroll
        for (int k = 0; k < 8; ++k) { const float v = __uint_as_float((unsigned)(unsigned short)qr[d0][k] << 16); qn2 += v * v; }
      { auto rr = __builtin_amdgcn_permlane32_swap(__float_as_uint(qn2), __float_as_uint(qn2), false, false); qn2 = __uint_as_float(rr[0]) + __uint_as_float(rr[1]); }
      float g = __builtin_sqrtf(qn2) * kmaxn - mhat;
      #pragma unroll
      for (int o_ = 1; o_ < 32; o_ <<= 1) g = fmaxf(g, __shfl_xor(g, o_));
      float* gx = (float*)(shm + LDS_OST);
      if (lane == 0) gx[wid] = g;
      asm volatile("s_waitcnt lgkmcnt(0)\n\ts_barrier" ::: "memory");
      float gw = gx[0];
      #pragma unroll
      for (int w_ = 1; w_ < NW; ++w_) gw = fmaxf(gw, gx[w_]);
      const float* tabf = (const float*)(shm + LDS_TAB);
      const bool c0 = lane < NT && (gw + tabf[64 * lane + 63] < -40.f), c1 = lane + 64 < NT && (gw + tabf[64 * (lane + 64) + 63] < -40.f);
      const unsigned long long b0 = __ballot(c0), b1 = __ballot(c1);
      int nskip = (b0 == ~0ull) ? 64 + (int)__builtin_ctzll(~b1 | (1ull << 63)) : (int)__builtin_ctzll(~b0);
      int ne = NT - nskip; ne = ne < 8 ? 8 : ne; ne += ne & 1;
      NE = __builtin_amdgcn_readfirstlane(ne);
    }
    STEP(pB0, pB1, pA0, pA1, t, (t + 3 < NE), (t + 1 < NE), (t + 1 < NE));         ENDW(t);     RESC(); ROT();
    STEP(pA0, pA1, pB0, pB1, t + 1, (t + 4 < NE), (t + 2 < NE), (t + 2 < NE));     ENDW(t + 1); RESC(); ROT();
  }
  STEP(pB0, pB1, pA0, pA1, NE - 1, false, false, false); RESC();
  { float sacc = pB0[0] + pB0[1]; _Pragma("unroll") for (int r = 2; r < 16; ++r) sacc += pB0[r]; _Pragma("unroll") for (int r = 0; r < 16; ++r) sacc += pB1[r]; l_reg += sacc;
    pw0 = (u32x4){PKW(pB0, 0), PKW(pB0, 2), PKW(pB0, 4), PKW(pB0, 6)}; pw1 = (u32x4){PKW(pB0, 8), PKW(pB0, 10), PKW(pB0, 12), PKW(pB0, 14)}; pw2 = (u32x4){PKW(pB1, 0), PKW(pB1, 2), PKW(pB1, 4), PKW(pB1, 6)}; pw3 = (u32x4){PKW(pB1, 8), PKW(pB1, 10), PKW(pB1, 12), PKW(pB1, 14)};
    SBAR(); pv(o, vb0 + sl_cur, PAF(0), PAF(1), PAF(2), PAF(3)); }
  #undef PKW
  #undef PAF
  #undef VFR
  #undef PIN
  #undef MX3
  #undef GAPA
  #undef GAPB
  #undef EX
  #undef VRD
  #undef KRD
  #undef STEP
  #undef ENDW
  #undef CI0
  { auto rr = __builtin_amdgcn_permlane32_swap(__float_as_uint(l_reg), __float_as_uint(l_reg), false, false); l_reg = __uint_as_float(rr[0]) + __uint_as_float(rr[1]); }
  if (hi == 0) wsf[32 + r32] = l_reg; asm volatile("s_waitcnt lgkmcnt(0)" ::: "memory");
  float rli[16];
  #pragma unroll
  for (int r = 0; r < 16; ++r) rli[r] = __builtin_amdgcn_rcpf(wsf[32 + crow(r, hi)]);
  bf16* Ow = O + (long)(q0 + wid * QBLK) * po;
  { bf16* stg = (bf16*)(shm + LDS_OST) + wid * 2048;
    #pragma unroll
    for (int r = 0; r < 16; ++r) { const int orow = crow(r, hi);
      #pragma unroll
      for (int d0 = 0; d0 < 2; ++d0) stg[orow * 64 + d0 * 32 + r32] = __float2bfloat16(o[d0][r] * rli[r]); }
    asm volatile("s_waitcnt lgkmcnt(0)" ::: "memory");
    #pragma unroll
    for (int i = 0; i < 4; ++i) { const int row = i * 8 + (lane >> 3), ch = lane & 7; const u32x4 v = *(const u32x4*)(stg + row * 64 + ch * 8); *(u32x4*)(Ow + (long)row * po + ch * 8) = v; } }
  asm volatile("s_waitcnt lgkmcnt(0)\n\ts_barrier" ::: "memory");
  #undef DMA_K
  #undef DMA_V
  #undef CMASK
  #undef BIASFILL
  #undef START
  #undef RESC
  #undef ROT
  #undef TILE
}

constexpr int DQB = 128, D_NSLOT = 4, D_VSLOT = 16384, D_LDS_K = 0, D_LDS_V = D_NSLOT * SLOTB, D_LDS_X = 0, D_LDS_STG = 65536, D_LDS_WS = D_LDS_V + D_NSLOT * D_VSLOT, D_LDS_ML = D_LDS_WS + NW * 256, D_LDS_BYTES = D_LDS_ML + NW * 256;
static_assert(D_LDS_STG + NW * 4096 <= D_LDS_WS, "O staging overlays the rings only");
template <int THRL> __device__ __forceinline__ void diff_unit(int qb, const bf16* Q, const bf16* __restrict__ K, const bf16* __restrict__ V, bf16* O, int po, char* shm) {
  int tid_ = threadIdx.x; asm volatile("" : "+v"(tid_));
  const int tid = tid_, lane = tid & 63, r32 = lane & 31, hi = lane >> 5; const int wid = __builtin_amdgcn_readfirstlane(tid >> 6);
  const int pr = wid & 3, kh = wid >> 2;
  const int q0 = qb * DQB;
  const bf16* Qw = Q + (long)(q0 + pr * QBLK) * PQ;
  const unsigned lds0 = (unsigned)(uintptr_t)shm;
  float* wsf = (float*)(shm + D_LDS_WS) + wid * 64;
  const int NT = (q0 + DQB) / KVBLK;
  const bf16* ksrc = K + (long)lane * PQ + wid * 8;
  const bf16* vsrc = V + (long)(16 * (wid & 3) + (lane >> 2)) * PQ + (wid >> 2) * 32 + (lane & 3) * 8;
  const unsigned kdst = lds0 + D_LDS_K + wid * 1024, vdst = lds0 + D_LDS_V + wid * 1024;
  #define KSL(x) (((x) & 3) * SLOTB)
  #define VSL(x) (((x) & 3) * D_VSLOT)
  #define DMA_K(t) glds16(ksrc + (long)(t) * KVBLK * PQ, (unsigned)__builtin_amdgcn_readfirstlane(kdst + KSL(t)))
  #define DMA_V(t) do { glds16(vsrc + (long)(t) * KVBLK * PQ, (unsigned)__builtin_amdgcn_readfirstlane(vdst + VSL(t))); \
                        glds16(vsrc + (long)(t) * KVBLK * PQ + 64, (unsigned)__builtin_amdgcn_readfirstlane(vdst + VSL(t) + 8192)); } while (0)
  bf16x8 kf[4];
  const lds_cptr shm3 = (lds_cptr)shm;
  const lds_cptr kp0 = shm3 + D_LDS_K + hi * 1024 + r32 * 16 + kh * 512;
  const lds_cptr vp0 = shm3 + D_LDS_V + ((lane >> 4) & 1) * 32 + (lane & 3) * 8 + (4 * hi + ((lane & 15) >> 2)) * 64 + kh * 2048;
  DMA_K(0); DMA_V(0); DMA_K(1); DMA_V(1);
  bf16x8 qr[4];
  #pragma unroll
  for (int d0 = 0; d0 < 4; ++d0) qr[d0] = *reinterpret_cast<const __attribute__((address_space(1))) bf16x8*>((const __attribute__((address_space(1))) char*)(const void*)&Qw[(long)r32 * PQ + d0 * 16 + hi * 8]);
  float mhat = 0.f, l_reg = 0.f; f32x16 o[4]; o[0] = f32x16{}; o[1] = f32x16{}; o[2] = f32x16{}; o[3] = f32x16{}; f32x16 negm = f32x16{}; asm volatile("" : "+v"(negm));
  const int qrel = pr * QBLK + r32;
  #define CMASK(P, t) do { const int jb_ = (t) - (NT - 2); if (jb_ >= 0) { const int kb_ = 64 * jb_ + 32 * kh + 4 * hi; \
      _Pragma("unroll") for (int r = 0; r < 16; ++r) { if (kb_ + (r & 3) + 8 * (r >> 2) > qrel) P[r] = -INFINITY; } } } while (0)
  bool resc = false;
  #define RESC() do { if (resc) { asm volatile("s_waitcnt lgkmcnt(0)" ::: "memory"); \
      _Pragma("unroll") for (int d_ = 0; d_ < 4; ++d_) _Pragma("unroll") for (int r = 0; r < 16; ++r) o[d_][r] *= wsf[crow(r, hi)]; } } while (0)
  f32x16 pA, pB;
  #define KLD(j, base) kf[j] = *(const __attribute__((address_space(3))) bf16x8*)((base) + (j) * 2048)
  DMA_K(2); DMA_K(3);
  WAIT_BAR(7);
  { KLD(0, kp0); KLD(1, kp0); KLD(2, kp0); KLD(3, kp0);
    pA = __builtin_amdgcn_mfma_f32_32x32x16_bf16(kf[0], qr[0], negm, 0, 0, 0); pA = __builtin_amdgcn_mfma_f32_32x32x16_bf16(kf[1], qr[1], pA, 0, 0, 0);
    pA = __builtin_amdgcn_mfma_f32_32x32x16_bf16(kf[2], qr[2], pA, 0, 0, 0); pA = __builtin_amdgcn_mfma_f32_32x32x16_bf16(kf[3], qr[3], pA, 0, 0, 0); }
  CMASK(pA, 0);
  { float a = fmaxf(fmaxf(pA[0], pA[1]), pA[2]);
    #pragma unroll
    for (int r = 3; r < 15; r += 2) a = fmaxf(fmaxf(a, pA[r]), pA[r + 1]);
    float rm = fmaxf(a, pA[15]); { auto rr = __builtin_amdgcn_permlane32_swap(__float_as_uint(rm), __float_as_uint(rm), false, false); rm = fmaxf(__uint_as_float(rr[0]), __uint_as_float(rr[1])); }
    const float dl = fmaxf(rm, -1.0e4f);
    mhat += dl;
    #pragma unroll
    for (int r = 0; r < 16; ++r) pA[r] = __builtin_amdgcn_exp2f(pA[r] - dl);
    #pragma unroll
    for (int r = 0; r < 16; ++r) negm[r] = -mhat;
    asm volatile("" : "+v"(negm)); }
  WAIT_BAR(4);
  if (4 < NT) DMA_K(4); if (2 < NT) DMA_V(2);
  { const lds_cptr kb_ = kp0 + KSL(1); KLD(0, kb_); KLD(1, kb_); KLD(2, kb_); KLD(3, kb_); }
  if (NT > 4) { WAIT_BAR(4); } else if (NT == 4) { WAIT_BAR(3); } else { WAIT_BAR(1); }
  s16x4 vlo[8], vhi[8]; u32x4 pw0, pw1;
  #define PKW(P, B) cvtpk_s(P[B], P[B + 1])
  #define PAF(k) __builtin_bit_cast(bf16x8, pw##k)
  #define VFR(i) (bf16x8){vlo[i][0], vlo[i][1], vlo[i][2], vlo[i][3], vhi[i][0], vhi[i][1], vhi[i][2], vhi[i][3]}
  #define PIN(x) asm volatile("" : "+v"(x))
  #define MX3(a, b, c) __builtin_fmaxf(__builtin_fmaxf((a), (b)), (c))
  #define EX(v) __builtin_amdgcn_exp2f(v)
  #define VRD(i) do { vlo[i] = vtr(vp_ + (((i) & 3) * 4096 + ((i) >> 2) * 1024)); vhi[i] = vtr(vp_ + (((i) & 3) * 4096 + ((i) >> 2) * 1024 + 512)); } while (0)
  #define GAPA(MF, A0, A1, A2, A3, W0, W1, PW) do { MF; sacc += A0; sacc += A1; sacc += A2; sacc += A3; PIN(sacc); W0; W1; PIN(PW); SBAR(); } while (0)
  #define GAPB(MF, X, B) do { MF; X[B] = EX(X[B]); X[B + 1] = EX(X[B + 1]); PIN(X); SBAR(); } while (0)
  #define STEP(C, P, t) do { SBAR(); \
    if ((t) + 4 < NT) { DMA_K((t) + 4); } if ((t) + 2 < NT) { DMA_V((t) + 2); } SBAR(); \
    const lds_cptr vp_ = vp0 + VSL((t) - 1); \
    VRD(0); VRD(1); SBAR(); float sacc = (P[0] + P[1]); \
    GAPA(C = __builtin_amdgcn_mfma_f32_32x32x16_bf16(kf[0], qr[0], negm, 0, 0, 0), P[2], P[3], P[4], P[5],     pw0[0] = PKW(P, 0), pw0[1] = PKW(P, 2), pw0); \
    VRD(2); VRD(3); SBAR(); \
    GAPA(C = __builtin_amdgcn_mfma_f32_32x32x16_bf16(kf[1], qr[1], C, 0, 0, 0),    P[6], P[7], P[8], P[9],     pw0[2] = PKW(P, 4), pw0[3] = PKW(P, 6), pw0); \
    VRD(4); VRD(5); SBAR(); \
    GAPA(C = __builtin_amdgcn_mfma_f32_32x32x16_bf16(kf[2], qr[2], C, 0, 0, 0),    P[10], P[11], P[12], P[13], pw1[0] = PKW(P, 8), pw1[1] = PKW(P, 10), pw1); \
    VRD(6); VRD(7); SBAR(); \
    GAPA(C = __builtin_amdgcn_mfma_f32_32x32x16_bf16(kf[3], qr[3], C, 0, 0, 0),    P[14], P[15], 0.f, 0.f,     pw1[2] = PKW(P, 12), pw1[3] = PKW(P, 14), pw1); \
    l_reg += sacc; \
    CMASK(C, t); \
    { float a = MX3(C[0], C[1], C[2]); \
      _Pragma("unroll") for (int r = 3; r < 15; r += 2) a = MX3(a, C[r], C[r + 1]); \
      float rm = __builtin_fmaxf(a, C[15]); { auto rr = __builtin_amdgcn_permlane32_swap(__float_as_uint(rm), __float_as_uint(rm), false, false); rm = __builtin_fmaxf(__uint_as_float(rr[0]), __uint_as_float(rr[1])); } \
      resc = false; \
      if (__builtin_expect(__any(rm > (float)THRL), 0)) { const float dl = __builtin_fmaxf(rm, 0.f); mhat += dl; \
        _Pragma("unroll") for (int r = 0; r < 16; ++r) C[r] -= dl; \
        _Pragma("unroll") for (int r = 0; r < 16; ++r) negm[r] = -mhat; asm volatile("" : "+v"(negm)); \
        const float f = __builtin_amdgcn_exp2f(-dl); l_reg *= f; if (hi == 0) wsf[r32] = f; resc = true; } } \
    SBAR(); \
    const bool gl_ = (t) + 1 < NT; const lds_cptr kn_ = kp0 + KSL((t) + 1); \
    GAPB(o[0] = __builtin_amdgcn_mfma_f32_32x32x16_bf16(PAF(0), VFR(0), o[0], 0, 0, 0), C, 0); \
    GAPB(o[1] = __builtin_amdgcn_mfma_f32_32x32x16_bf16(PAF(0), VFR(1), o[1], 0, 0, 0), C, 2); \
    GAPB(o[2] = __builtin_amdgcn_mfma_f32_32x32x16_bf16(PAF(0), VFR(2), o[2], 0, 0, 0), C, 4); \
    GAPB(o[3] = __builtin_amdgcn_mfma_f32_32x32x16_bf16(PAF(0), VFR(3), o[3], 0, 0, 0), C, 6); \
    if (gl_) { KLD(0, kn_); KLD(1, kn_); SBAR(); } \
    GAPB(o[0] = __builtin_amdgcn_mfma_f32_32x32x16_bf16(PAF(1), VFR(4), o[0], 0, 0, 0), C, 8); \
    GAPB(o[1] = __builtin_amdgcn_mfma_f32_32x32x16_bf16(PAF(1), VFR(5), o[1], 0, 0, 0), C, 10); \
    if (gl_) { KLD(2, kn_); KLD(3, kn_); SBAR(); } \
    GAPB(o[2] = __builtin_amdgcn_mfma_f32_32x32x16_bf16(PAF(1), VFR(6), o[2], 0, 0, 0), C, 12); \
    GAPB(o[3] = __builtin_amdgcn_mfma_f32_32x32x16_bf16(PAF(1), VFR(7), o[3], 0, 0, 0), C, 14); \
    } while (0)
  #define ENDW(tt) do { const int d_ = NT - (tt); if (d_ >= 5) { WAIT_BAR(6); } else if (d_ == 4) { WAIT_BAR(5); } else if (d_ == 3) { WAIT_BAR(4); } else { WAIT_BAR(2); } } while (0)
  int t = 1;
  for (; t + 1 < NT; t += 2) {
    STEP(pB, pA, t);         ENDW(t);     RESC();
    STEP(pA, pB, t + 1);     ENDW(t + 1); RESC();
  }
  STEP(pB, pA, NT - 1); RESC();
  WAIT_BAR(0);
  { float sacc = pB[0] + pB[1];
    #pragma unroll
    for (int r = 2; r < 16; ++r) sacc += pB[r];
    l_reg += sacc;
    pw0 = (u32x4){PKW(pB, 0), PKW(pB, 2), PKW(pB, 4), PKW(pB, 6)}; pw1 = (u32x4){PKW(pB, 8), PKW(pB, 10), PKW(pB, 12), PKW(pB, 14)};
    SBAR();
    const lds_cptr vp_ = vp0 + VSL(NT - 1);
    VRD(0); VRD(1); VRD(2); VRD(3); VRD(4); VRD(5); VRD(6); VRD(7);
    #pragma unroll
    for (int i = 0; i < 4; ++i) o[i] = __builtin_amdgcn_mfma_f32_32x32x16_bf16(PAF(0), VFR(i), o[i], 0, 0, 0);
    #pragma unroll
    for (int i = 0; i < 4; ++i) o[i] = __builtin_amdgcn_mfma_f32_32x32x16_bf16(PAF(1), VFR(4 + i), o[i], 0, 0, 0); }
  #undef PKW
  #undef PAF
  #undef VFR
  #undef PIN
  #undef MX3
  #undef GAPA
  #undef GAPB
  #undef EX
  #undef VRD
  #undef STEP
  #undef ENDW
  #undef KLD
  #undef KSL
  #undef VSL
  { auto rr = __builtin_amdgcn_permlane32_swap(__float_as_uint(l_reg), __float_as_uint(l_reg), false, false); l_reg = __uint_as_float(rr[0]) + __uint_as_float(rr[1]); }
  float* ml = (float*)(shm + D_LDS_ML);
  if (hi == 0) { ml[wid * 64 + r32] = mhat; ml[wid * 64 + 32 + r32] = l_reg; }
  asm volatile("s_waitcnt lgkmcnt(0)\n\ts_barrier" ::: "memory");
  { const float mo = ml[(wid ^ 4) * 64 + r32], lo_ = ml[(wid ^ 4) * 64 + 32 + r32];
    const float M = fmaxf(mhat, mo), as = __builtin_amdgcn_exp2f(mhat - M), ao = __builtin_amdgcn_exp2f(mo - M);
    const float sc = as * __builtin_amdgcn_rcpf(l_reg * as + lo_ * ao);
    if (hi == 0) wsf[r32] = sc; }
  asm volatile("s_waitcnt lgkmcnt(0)" ::: "memory");
  float rli[16];
  #pragma unroll
  for (int r = 0; r < 16; ++r) rli[r] = wsf[crow(r, hi)];
  f32x16 keep0, keep1, send0, send1;
  #pragma unroll
  for (int r = 0; r < 16; ++r) { const float a0 = o[0][r] * rli[r], a1 = o[1][r] * rli[r], a2 = o[2][r] * rli[r], a3 = o[3][r] * rli[r];
    keep0[r] = kh ? a2 : a0; keep1[r] = kh ? a3 : a1; send0[r] = kh ? a0 : a2; send1[r] = kh ? a1 : a3; }
  { float* xs = (float*)(shm + D_LDS_X) + wid * 2048 + lane;
    #pragma unroll
    for (int r = 0; r < 16; ++r) { xs[r * 64] = send0[r]; xs[1024 + r * 64] = send1[r]; } }
  asm volatile("s_waitcnt lgkmcnt(0)\n\ts_barrier" ::: "memory");
  { const float* xr = (const float*)(shm + D_LDS_X) + (wid ^ 4) * 2048 + lane;
    #pragma unroll
    for (int r = 0; r < 16; ++r) { keep0[r] += xr[r * 64]; keep1[r] += xr[1024 + r * 64]; } }
  bf16* Ow = O + (long)(q0 + pr * QBLK) * po + kh * 64;
  { bf16* stg = (bf16*)(shm + D_LDS_STG) + wid * 2048;
    #pragma unroll
    for (int r = 0; r < 16; ++r) { const int orow = crow(r, hi); stg[orow * 64 + r32] = __float2bfloat16(keep0[r]); stg[orow * 64 + 32 + r32] = __float2bfloat16(keep1[r]); }
    asm volatile("s_waitcnt lgkmcnt(0)" ::: "memory");
    #pragma unroll
    for (int i = 0; i < 4; ++i) { const int row = i * 8 + (lane >> 3), ch = lane & 7; const u32x4 v = *(const u32x4*)(stg + row * 64 + ch * 8); *(__attribute__((address_space(1))) u32x4*)(void*)(Ow + (long)row * po + ch * 8) = v; } }
  asm volatile("s_waitcnt lgkmcnt(0)\n\ts_barrier" ::: "memory");
  #undef DMA_K
  #undef DMA_V
  #undef CMASK
  #undef RESC
}
template <int THRL> __device__ __forceinline__ void diff_unit2(int qb, const bf16* Q, const bf16* __restrict__ K, const bf16* __restrict__ V, bf16* O, int po, const bf16* O1, float lam, float post, const float* gain, char* shm) {
  constexpr bool BIAS = false; constexpr int W_LDS_V = NSLOT * SLOTB, W_LDS_WS = W_LDS_V + NSLOT * 16384, W_LDS_OST = 0;
  int tid_ = threadIdx.x; asm volatile("" : "+v"(tid_));
  const int tid = tid_, lane = tid & 63, r32 = lane & 31, hi = lane >> 5; const int wid = __builtin_amdgcn_readfirstlane(tid >> 6);
  const int q0 = qb * QB;
  const bf16* Qw = Q + (long)(q0 + wid * QBLK) * PQ;
  const unsigned lds0 = (unsigned)(uintptr_t)shm;
  float* wsf = (float*)(shm + W_LDS_WS) + wid * 64;
  const int NT = (q0 + QB) / KVBLK;
  const bf16* ksrc = K + (long)lane * PQ + wid * 8;
  const bf16* vsrc = V + (long)(16 * (wid & 3) + (lane >> 2)) * PQ + (wid >> 2) * 32 + (lane & 3) * 8;
  const unsigned kdst = lds0 + LDS_K + wid * 1024, vdst = lds0 + W_LDS_V + wid * 1024;
  #define DMA_K(t, slot) glds16(ksrc + (long)(t) * KVBLK * PQ, (unsigned)__builtin_amdgcn_readfirstlane(kdst + (slot)))
  #define DMA_V(t, slot) do { glds16(vsrc + (long)(t) * KVBLK * PQ, (unsigned)__builtin_amdgcn_readfirstlane(vdst + 2 * (slot))); \
                              glds16(vsrc + (long)(t) * KVBLK * PQ + 64, (unsigned)__builtin_amdgcn_readfirstlane(vdst + 2 * (slot) + 8192)); } while (0)
  const char* Kbase = shm + LDS_K; bf16x8 kf[8];
  const lds_cptr shm3 = (lds_cptr)shm; const lds_cptr kp0 = shm3 + LDS_K + hi * 1024 + r32 * 16; const lds_cptr vp0 = shm3 + W_LDS_V + ((lane >> 4) & 1) * 32 + (lane & 3) * 8 + (4 * hi + ((lane & 15) >> 2)) * 64;
  DMA_K(0, 0); DMA_V(0, 0); DMA_K(1, SLOTB);
  bf16x8 qr[4];
  #pragma unroll
  for (int d0 = 0; d0 < 4; ++d0) qr[d0] = *reinterpret_cast<const bf16x8*>(&Qw[(long)r32 * PQ + d0 * 16 + hi * 8]);
  float mhat = 0.f, l_reg = 0.f; f32x16 o[4]; o[0] = f32x16{}; o[1] = f32x16{}; o[2] = f32x16{}; o[3] = f32x16{}; f32x16 negm = f32x16{}; asm volatile("" : "+v"(negm));
  const int qrel = wid * QBLK + r32;
  #define CMASK(P0, P1, t) do { int jb_ = (t) - (NT - 4); if (jb_ >= 0) cmask(P0, P1, jb_, qrel, hi); } while (0)
  bool resc = false;
  #define START(P0, P1) do { const float rm = rowmax(P0, P1); resc = false; \
    { const float dl = rm; mhat = fadd_s(mhat, dl); \
      _Pragma("unroll") for (int r = 0; r < 16; ++r) { P0[r] = fsub_s(P0[r], dl); P1[r] = fsub_s(P1[r], dl); } \
      if (!BIAS) { _Pragma("unroll") for (int r = 0; r < 16; ++r) negm[r] = -mhat; asm volatile("" : "+v"(negm)); } } \
    _Pragma("unroll") for (int r = 0; r < 16; ++r) P0[r] = __builtin_amdgcn_exp2f(P0[r]); } while (0)
  #define RESC() do { if (resc) { asm volatile("s_waitcnt lgkmcnt(0)" ::: "memory"); \
      _Pragma("unroll") for (int r = 0; r < 16; ++r) { const float f_ = wsf[crow(r, hi)]; o[0][r] *= f_; o[1][r] *= f_; o[2][r] *= f_; o[3][r] *= f_; } } } while (0)
  f32x16 pA0, pA1, pB0, pB1;
  int sl_prev = 0, sl_cur = 0, sl_next = SLOTB;
  #define ROT() do { sl_prev = sl_cur; sl_cur = sl_next; sl_next = (sl_next == (NSLOT - 1) * SLOTB) ? 0 : sl_next + SLOTB; } while (0)
  DMA_K(2, 2 * SLOTB);
  WAIT_BAR(4);
  qkt(pA0, pA1, Kbase, qr, negm, negm, r32, hi);
  asm volatile("s_nop 15\n\ts_nop 7" : "+v"(pA0), "+v"(pA1)); CMASK(pA0, pA1, 0);
  START(pA0, pA1);
  _Pragma("unroll") for (int r = 0; r < 16; ++r) pA1[r] = __builtin_amdgcn_exp2f(pA1[r]);
  WAIT_BAR(0);
  DMA_K(3, 0); DMA_V(1, SLOTB);
  ROT();
  kload8(kf, kp0 + sl_cur);
  WAIT_BAR(3);
  s16x4 vlo[8], vhi[8]; u32x4 pw0, pw1, pw2, pw3;
  #define PKW(P, B) cvtpk_s(P[B], P[B + 1])
  #define PAF(k) __builtin_bit_cast(bf16x8, pw##k)
  #define VFR(i) (bf16x8){vlo[i][0], vlo[i][1], vlo[i][2], vlo[i][3], vhi[i][0], vhi[i][1], vhi[i][2], vhi[i][3]}
  #define PIN(x) asm volatile("" : "+v"(x))
  #define MX3(a, b, c) __builtin_fmaxf(__builtin_fmaxf((a), (b)), (c))
  #define GAPA(MF, A0, A1, A2, A3, W0, W1, PW) do { MF; sacc += A0; sacc += A1; sacc += A2; sacc += A3; PIN(sacc); W0; W1; PIN(PW); SBAR(); } while (0)
  #define EX(v) __builtin_amdgcn_exp2f(v)
  #define GAPB(MF, X, B) do { MF; X[B] = EX(X[B]); X[B + 1] = EX(X[B + 1]); X[B + 2] = EX(X[B + 2]); X[B + 3] = EX(X[B + 3]); PIN(X); SBAR(); } while (0)
  #define VRD(i) do { vlo[i] = vtr(vp_ + (((i) >> 2) * 4096 + ((i) & 3) * 1024)); vhi[i] = vtr(vp_ + (((i) >> 2) * 4096 + ((i) & 3) * 1024 + 512)); } while (0)
  #define VRD2(i) do { vlo[i] = vtr(vp_ + (8192 + ((i) >> 2) * 4096 + ((i) & 3) * 1024)); vhi[i] = vtr(vp_ + (8192 + ((i) >> 2) * 4096 + ((i) & 3) * 1024 + 512)); } while (0)
  #define KRD(G, j) do { if (G) { kload2(kf, kp0 + sl_next, j); SBAR(); } } while (0)
  #define CI0(C0) (BIAS ? C0 : negm)
  #define STEP(C0, C1, P0, P1, t, GK, GV, GL) do { SBAR(); \
    if (GK) { DMA_K((t) + 3, sl_cur); } if (GV) { DMA_V((t) + 1, sl_next); } SBAR(); \
    const lds_cptr vp_ = vp0 + 2 * sl_prev; \
    VRD(0); SBAR(); float sacc = (P0[0] + P0[1]); \
    GAPA(C0 = __builtin_amdgcn_mfma_f32_32x32x16_bf16(kf[0], qr[0], CI0(C0), 0, 0, 0), P0[2], P0[3], P0[4], P0[5],     pw0[0] = PKW(P0, 0), pw0[1] = PKW(P0, 2), pw0); \
    VRD(4); SBAR(); GAPA(C1 = __builtin_amdgcn_mfma_f32_32x32x16_bf16(kf[1], qr[0], CI0(C1), 0, 0, 0), P0[6], P0[7], P0[8], P0[9],     pw0[2] = PKW(P0, 4), pw0[3] = PKW(P0, 6), pw0); \
    VRD(1); SBAR(); GAPA(C0 = __builtin_amdgcn_mfma_f32_32x32x16_bf16(kf[2], qr[1], C0, 0, 0, 0),   P0[10], P0[11], P0[12], P0[13], pw1[0] = PKW(P0, 8), pw1[1] = PKW(P0, 10), pw1); \
    VRD(5); SBAR(); GAPA(C1 = __builtin_amdgcn_mfma_f32_32x32x16_bf16(kf[3], qr[1], C1, 0, 0, 0),   P0[14], P0[15], P1[0], P1[1],   pw1[2] = PKW(P0, 12), pw1[3] = PKW(P0, 14), pw1); \
    VRD(2); SBAR(); GAPA(C0 = __builtin_amdgcn_mfma_f32_32x32x16_bf16(kf[4], qr[2], C0, 0, 0, 0),   P1[2], P1[3], P1[4], P1[5],     pw2[0] = PKW(P1, 0), pw2[1] = PKW(P1, 2), pw2); \
    VRD(6); SBAR(); GAPA(C1 = __builtin_amdgcn_mfma_f32_32x32x16_bf16(kf[5], qr[2], C1, 0, 0, 0),   P1[6], P1[7], P1[8], P1[9],     pw2[2] = PKW(P1, 4), pw2[3] = PKW(P1, 6), pw2); \
    VRD(3); SBAR(); GAPA(C0 = __builtin_amdgcn_mfma_f32_32x32x16_bf16(kf[6], qr[3], C0, 0, 0, 0),   P1[10], P1[11], P1[12], P1[13], pw3[0] = PKW(P1, 8), pw3[1] = PKW(P1, 10), pw3); \
    VRD(7); SBAR(); GAPA(C1 = __builtin_amdgcn_mfma_f32_32x32x16_bf16(kf[7], qr[3], C1, 0, 0, 0),   P1[14], P1[15], 0.f, 0.f,       pw3[2] = PKW(P1, 12), pw3[3] = PKW(P1, 14), pw3); \
    l_reg += sacc; \
    CMASK(C0, C1, t); \
    { float a = MX3(C0[0], C0[1], C1[0]), b = MX3(C0[2], C0[3], C1[1]); a = MX3(a, C1[2], C1[3]); \
      _Pragma("unroll") for (int r = 4; r < 16; r += 4) { a = MX3(a, C0[r], C0[r + 1]); b = MX3(b, C0[r + 2], C0[r + 3]); a = MX3(a, C1[r], C1[r + 1]); b = MX3(b, C1[r + 2], C1[r + 3]); } \
      float rm = __builtin_fmaxf(a, b); { auto rr = __builtin_amdgcn_permlane32_swap(__float_as_uint(rm), __float_as_uint(rm), false, false); rm = __builtin_fmaxf(__uint_as_float(rr[0]), __uint_as_float(rr[1])); } \
      resc = false; \
      if (__builtin_expect(__any(rm > (float)THRL), 0)) { const float dl = __builtin_fmaxf(rm, 0.f); mhat += dl; \
        _Pragma("unroll") for (int r = 0; r < 16; ++r) { C0[r] -= dl; C1[r] -= dl; } \
        if (!BIAS) { _Pragma("unroll") for (int r = 0; r < 16; ++r) negm[r] = -mhat; asm volatile("" : "+v"(negm)); } \
        const float f = __builtin_amdgcn_exp2f(-dl); l_reg *= f; if (hi == 0) wsf[r32] = f; resc = true; } } \
    SBAR(); \
    GAPB(o[0] = __builtin_amdgcn_mfma_f32_32x32x16_bf16(PAF(0), VFR(0), o[0], 0, 0, 0), C0, 0); \
    GAPB(o[1] = __builtin_amdgcn_mfma_f32_32x32x16_bf16(PAF(0), VFR(4), o[1], 0, 0, 0), C0, 4); \
    KRD(GL, 0); GAPB(o[0] = __builtin_amdgcn_mfma_f32_32x32x16_bf16(PAF(1), VFR(1), o[0], 0, 0, 0), C0, 8); \
    KRD(GL, 1); GAPB(o[1] = __builtin_amdgcn_mfma_f32_32x32x16_bf16(PAF(1), VFR(5), o[1], 0, 0, 0), C0, 12); \
    KRD(GL, 2); GAPB(o[0] = __builtin_amdgcn_mfma_f32_32x32x16_bf16(PAF(2), VFR(2), o[0], 0, 0, 0), C1, 0); \
    KRD(GL, 3); GAPB(o[1] = __builtin_amdgcn_mfma_f32_32x32x16_bf16(PAF(2), VFR(6), o[1], 0, 0, 0), C1, 4); \
    VRD2(0); VRD2(4); SBAR(); \
    GAPB(o[0] = __builtin_amdgcn_mfma_f32_32x32x16_bf16(PAF(3), VFR(3), o[0], 0, 0, 0), C1, 8); \
    VRD2(1); VRD2(5); SBAR(); \
    GAPB(o[1] = __builtin_amdgcn_mfma_f32_32x32x16_bf16(PAF(3), VFR(7), o[1], 0, 0, 0), C1, 12); \
    VRD2(2); VRD2(6); SBAR(); \
    o[2] = __builtin_amdgcn_mfma_f32_32x32x16_bf16(PAF(0), VFR(0), o[2], 0, 0, 0); SBAR(); \
    o[3] = __builtin_amdgcn_mfma_f32_32x32x16_bf16(PAF(0), VFR(4), o[3], 0, 0, 0); VRD2(3); VRD2(7); SBAR(); \
    o[2] = __builtin_amdgcn_mfma_f32_32x32x16_bf16(PAF(1), VFR(1), o[2], 0, 0, 0); SBAR(); \
    o[3] = __builtin_amdgcn_mfma_f32_32x32x16_bf16(PAF(1), VFR(5), o[3], 0, 0, 0); SBAR(); \
    o[2] = __builtin_amdgcn_mfma_f32_32x32x16_bf16(PAF(2), VFR(2), o[2], 0, 0, 0); SBAR(); \
    o[3] = __builtin_amdgcn_mfma_f32_32x32x16_bf16(PAF(2), VFR(6), o[3], 0, 0, 0); SBAR(); \
    o[2] = __builtin_amdgcn_mfma_f32_32x32x16_bf16(PAF(3), VFR(3), o[2], 0, 0, 0); SBAR(); \
    o[3] = __builtin_amdgcn_mfma_f32_32x32x16_bf16(PAF(3), VFR(7), o[3], 0, 0, 0); SBAR(); \
    } while (0)
  int t = 1;
  #undef CMASK
  #define CMASK(P0, P1, t) do {} while (0)
  for (; t + 5 < NT; t += 2) {
    STEP(pB0, pB1, pA0, pA1, t, true, true, true);     WAIT_BAR(3); RESC(); ROT();
    STEP(pA0, pA1, pB0, pB1, t + 1, true, true, true); WAIT_BAR(3); RESC(); ROT();
  }
  #undef CMASK
  #define CMASK(P0, P1, t) do { int jb_ = (t) - (NT - 4); if (jb_ >= 0) cmask(P0, P1, jb_, qrel, hi); } while (0)
  #define ENDW(tt) do { if ((tt) + 3 < NT) { WAIT_BAR(3); } else if ((tt) + 2 < NT) { WAIT_BAR(2); } else { WAIT_BAR(0); } } while (0)
  for (; t + 1 < NT; t += 2) {
    STEP(pB0, pB1, pA0, pA1, t, (t + 3 < NT), (t + 1 < NT), (t + 1 < NT));         ENDW(t);     RESC(); ROT();
    STEP(pA0, pA1, pB0, pB1, t + 1, (t + 4 < NT), (t + 2 < NT), (t + 2 < NT));     ENDW(t + 1); RESC(); ROT();
  }
  STEP(pB0, pB1, pA0, pA1, NT - 1, false, false, false); RESC();
  { float sacc = pB0[0] + pB0[1]; _Pragma("unroll") for (int r = 2; r < 16; ++r) sacc += pB0[r]; _Pragma("unroll") for (int r = 0; r < 16; ++r) sacc += pB1[r]; l_reg += sacc;
    pw0 = (u32x4){PKW(pB0, 0), PKW(pB0, 2), PKW(pB0, 4), PKW(pB0, 6)}; pw1 = (u32x4){PKW(pB0, 8), PKW(pB0, 10), PKW(pB0, 12), PKW(pB0, 14)}; pw2 = (u32x4){PKW(pB1, 0), PKW(pB1, 2), PKW(pB1, 4), PKW(pB1, 6)}; pw3 = (u32x4){PKW(pB1, 8), PKW(pB1, 10), PKW(pB1, 12), PKW(pB1, 14)};
    SBAR();
    { const lds_cptr vp_ = vp0 + 2 * sl_cur;
      VRD(0); VRD(1); VRD(2); VRD(3); VRD(4); VRD(5); VRD(6); VRD(7);
      o[0] = __builtin_amdgcn_mfma_f32_32x32x16_bf16(PAF(0), VFR(0), o[0], 0, 0, 0); o[1] = __builtin_amdgcn_mfma_f32_32x32x16_bf16(PAF(0), VFR(4), o[1], 0, 0, 0);
      o[0] = __builtin_amdgcn_mfma_f32_32x32x16_bf16(PAF(1), VFR(1), o[0], 0, 0, 0); o[1] = __builtin_amdgcn_mfma_f32_32x32x16_bf16(PAF(1), VFR(5), o[1], 0, 0, 0);
      o[0] = __builtin_amdgcn_mfma_f32_32x32x16_bf16(PAF(2), VFR(2), o[0], 0, 0, 0); o[1] = __builtin_amdgcn_mfma_f32_32x32x16_bf16(PAF(2), VFR(6), o[1], 0, 0, 0);
      o[0] = __builtin_amdgcn_mfma_f32_32x32x16_bf16(PAF(3), VFR(3), o[0], 0, 0, 0); o[1] = __builtin_amdgcn_mfma_f32_32x32x16_bf16(PAF(3), VFR(7), o[1], 0, 0, 0);
      SBAR();
      VRD2(0); VRD2(1); VRD2(2); VRD2(3); VRD2(4); VRD2(5); VRD2(6); VRD2(7);
      o[2] = __builtin_amdgcn_mfma_f32_32x32x16_bf16(PAF(0), VFR(0), o[2], 0, 0, 0); o[3] = __builtin_amdgcn_mfma_f32_32x32x16_bf16(PAF(0), VFR(4), o[3], 0, 0, 0);
      o[2] = __builtin_amdgcn_mfma_f32_32x32x16_bf16(PAF(1), VFR(1), o[2], 0, 0, 0); o[3] = __builtin_amdgcn_mfma_f32_32x32x16_bf16(PAF(1), VFR(5), o[3], 0, 0, 0);
      o[2] = __builtin_amdgcn_mfma_f32_32x32x16_bf16(PAF(2), VFR(2), o[2], 0, 0, 0); o[3] = __builtin_amdgcn_mfma_f32_32x32x16_bf16(PAF(2), VFR(6), o[3], 0, 0, 0);
      o[2] = __builtin_amdgcn_mfma_f32_32x32x16_bf16(PAF(3), VFR(3), o[2], 0, 0, 0); o[3] = __builtin_amdgcn_mfma_f32_32x32x16_bf16(PAF(3), VFR(7), o[3], 0, 0, 0); } }
  #undef PKW
  #undef PAF
  #undef VFR
  #undef PIN
  #undef MX3
  #undef GAPA
  #undef GAPB
  #undef EX
  #undef VRD
  #undef VRD2
  #undef KRD
  #undef STEP
  #undef ENDW
  #undef CI0
  { auto rr = __builtin_amdgcn_permlane32_swap(__float_as_uint(l_reg), __float_as_uint(l_reg), false, false); l_reg = __uint_as_float(rr[0]) + __uint_as_float(rr[1]); }
  if (hi == 0) wsf[32 + r32] = l_reg; asm volatile("s_waitcnt lgkmcnt(0)" ::: "memory");
  float rli[16];
  #pragma unroll
  for (int r = 0; r < 16; ++r) rli[r] = __builtin_amdgcn_rcpf(wsf[32 + crow(r, hi)]);
  bf16* Ow = O + (long)(q0 + wid * QBLK) * po;
  asm volatile("s_waitcnt lgkmcnt(0)\n\ts_barrier" ::: "memory");
  { bf16* stg = (bf16*)(shm + W_LDS_OST) + wid * 4096;
    #pragma unroll
    for (int r = 0; r < 16; ++r) { const int orow = crow(r, hi);
      #pragma unroll
      for (int d0 = 0; d0 < 4; ++d0) stg[orow * 128 + d0 * 32 + r32] = __float2bfloat16(o[d0][r] * rli[r]); }
    asm volatile("s_waitcnt lgkmcnt(0)" ::: "memory");
    if (O1 == nullptr) {
      #pragma unroll
      for (int i = 0; i < 8; ++i) { const int row = i * 4 + (lane >> 4), ch = lane & 15; const u32x4 v = *(const u32x4*)(stg + row * 128 + ch * 8); *(__attribute__((address_space(1))) u32x4*)(void*)(Ow + (long)row * po + ch * 8) = v; }
    } else {
      const bf16* O1w = O1 + (long)(q0 + wid * QBLK) * 512; const int ch = lane & 15;
      const f32x4 g0 = *(const f32x4*)(gain + ch * 8), g1 = *(const f32x4*)(gain + ch * 8 + 4);
      #pragma unroll
      for (int i = 0; i < 8; ++i) { const int row = i * 4 + (lane >> 4); const u32x4 v2 = *(const u32x4*)(stg + row * 128 + ch * 8);
        const u32x4 v1 = *(const __attribute__((address_space(1))) u32x4*)(const void*)(O1w + (long)row * 512 + ch * 8);
        float d[8];
        d[0] = pg8::bf_lo(v1.x) - lam * pg8::bf_lo(v2.x); d[1] = pg8::bf_hi(v1.x) - lam * pg8::bf_hi(v2.x); d[2] = pg8::bf_lo(v1.y) - lam * pg8::bf_lo(v2.y); d[3] = pg8::bf_hi(v1.y) - lam * pg8::bf_hi(v2.y);
        d[4] = pg8::bf_lo(v1.z) - lam * pg8::bf_lo(v2.z); d[5] = pg8::bf_hi(v1.z) - lam * pg8::bf_hi(v2.z); d[6] = pg8::bf_lo(v1.w) - lam * pg8::bf_lo(v2.w); d[7] = pg8::bf_hi(v1.w) - lam * pg8::bf_hi(v2.w);
        float ss = 0.f;
        #pragma unroll
        for (int k = 0; k < 8; ++k) ss += d[k] * d[k];
        ss += __shfl_xor(ss, 1); ss += __shfl_xor(ss, 2); ss += __shfl_xor(ss, 4); ss += __shfl_xor(ss, 8);
        const float rr_ = rsqrtf(ss * (1.f / 128.f) + SUBLN_EPS) * post;
        u32x4 w; w.x = pg8::cvt_pk(d[0] * rr_ * g0[0], d[1] * rr_ * g0[1]); w.y = pg8::cvt_pk(d[2] * rr_ * g0[2], d[3] * rr_ * g0[3]); w.z = pg8::cvt_pk(d[4] * rr_ * g1[0], d[5] * rr_ * g1[1]); w.w = pg8::cvt_pk(d[6] * rr_ * g1[2], d[7] * rr_ * g1[3]);
        *(__attribute__((address_space(1))) u32x4*)(void*)(Ow + (long)row * po + ch * 8) = w; }
    } }
  asm volatile("s_waitcnt lgkmcnt(0)\n\ts_barrier" ::: "memory");
  #undef DMA_K
  #undef DMA_V
  #undef CMASK
  #undef START
  #undef RESC
  #undef ROT
}
#undef SBAR
#undef WAIT_BAR
}

#ifndef MK_DENSE8
#define MK_DENSE8 2
#endif
constexpr size_t MiB = 1ull << 20;
constexpr size_t WS_CTL = 0, CTL_ZERO_BYTES = 1 * MiB;
constexpr size_t WS_SSQ = 926 * MiB;
constexpr size_t WS_LOGF = 2 * MiB, WS_CS2 = 4 * MiB, WS_COS = 6 * MiB, WS_SIN = 8 * MiB;
constexpr size_t WS_ROUTE = 10 * MiB;
constexpr size_t RT_CHOICE = WS_ROUTE, RT_GATES = WS_ROUTE + 256 * 1024, RT_CNT = WS_ROUTE + 768 * 1024, RT_TOK = WS_ROUTE + 1 * MiB, RT_GATE_S = WS_ROUTE + 2 * MiB, RT_TEXP = WS_ROUTE + 3 * MiB, RT_NT = RT_TEXP + 4096;
constexpr size_t WS_MEMN = 16 * MiB, WS_KM = 32 * MiB, WS_VT = 48 * MiB, WS_H = 64 * MiB;
constexpr size_t WS_WIN = 192 * MiB, WS_WOUT = 220 * MiB, WS_WMQ = 228 * MiB, WS_WMO = 236 * MiB, WS_WMKV = 244 * MiB, WS_WFF13 = 260 * MiB, WS_WFF2 = 282 * MiB, WS_WRT = 294 * MiB;
constexpr size_t WS_WE13 = 296 * MiB, WS_WE2 = 408 * MiB, WS_R = 464 * MiB, WS_H8 = 938 * MiB, WS_END = 1002 * MiB, WS_MT = WS_R + 400 * MiB, WS_VWT = WS_R + 416 * MiB;
constexpr size_t OUT_O1 = 0, OUT_O2 = 64 * MiB, OUT_MIX = 128 * MiB;
constexpr int CW_BAR = 4096, CW_KMX = 8192;
static_assert(WS_R + (size_t)MOE_ROWS * D_EXP * 2 <= WS_SSQ && WS_R + (size_t)T * QKVP * 2 <= WS_SSQ && WS_SSQ + (size_t)3 * T * 16 * 4 <= WS_H8 && WS_H8 + (size_t)T * DM <= WS_END, "R region");

constexpr int NWAVES = 8;
constexpr int RING_BYTES = 131072, LDSCTL_OFF = RING_BYTES, MISC_OFF = LDSCTL_OFF + 320, LDSX_OFF = RING_BYTES + 1024, LDSH_OFF = LDSX_OFF + 8192, LDSR_OFF = LDSH_OFF + 64;
constexpr int LDS_BYTES = 147456;
static_assert(LDSR_OFF + 2048 <= LDS_BYTES, "LDS map");
static_assert(attn_body::LDS_BYTES <= RING_BYTES && attn_body::D_LDS_BYTES <= RING_BYTES, "attention scratch inside the ring region");

#define GAS __attribute__((address_space(1)))
#define LAS __attribute__((address_space(3)))
typedef unsigned short bf16;
typedef unsigned v4u __attribute__((ext_vector_type(4)));
typedef float f32x4 __attribute__((ext_vector_type(4)));
typedef GAS unsigned gu32;
#define RLX_AGENT __ATOMIC_RELAXED, __HIP_MEMORY_SCOPE_AGENT
#define LDS_WAIT() asm volatile("s_waitcnt lgkmcnt(0)" ::: "memory")

#define XB_TMO      128
#define XB_XCNT(j)  (256  + 64 * (j))
#define XB_XSUB(j)  (1280 + 64 * (j))
#define XB_XGEN(j)  (2304 + 64 * (j))
#define XB_TOP      3328
#define XB_TOPGEN   3392
#define XCD_BAR_WORDS 3456
#define XB_SPIN_CAP (1u << 18)
__device__ __forceinline__ unsigned xb_ld(unsigned* p)              { return __hip_atomic_load(p, __ATOMIC_RELAXED, __HIP_MEMORY_SCOPE_AGENT); }
__device__ __forceinline__ unsigned xb_add(unsigned* p, unsigned v) { return __hip_atomic_fetch_add(p, v, __ATOMIC_RELAXED, __HIP_MEMORY_SCOPE_AGENT); }
__device__ __forceinline__ unsigned xb_xcc_id() { return (unsigned)__builtin_amdgcn_s_getreg((3 << 11) | 20) & 0xFu; }
#define XB_SPIN(cond, bar) do { unsigned _sp = 0; while (cond) { __builtin_amdgcn_s_sleep(1); \
    if ((++_sp & 255u) == 0u) { if (xb_ld(&(bar)[XB_TMO])) break; if (_sp > XB_SPIN_CAP) { atomicAdd(&(bar)[XB_TMO], 1u); break; } } } } while (0)
struct XcdBarrier { unsigned* bar; unsigned x; volatile LAS unsigned* st; };
__device__ __forceinline__ XcdBarrier xcd_barrier_post(unsigned* bar, volatile LAS unsigned* st) {
    XcdBarrier b; b.bar = bar; b.x = xb_xcc_id(); b.st = st;
    if (threadIdx.x == 0) (void)xb_add(&bar[XB_XCNT(b.x)], 1u);
    return b;
}
__device__ __forceinline__ void xcd_barrier_complete(unsigned* bar, unsigned x, unsigned& nloc, unsigned& nx) {
    const unsigned G = gridDim.x * gridDim.y * gridDim.z;
    unsigned sum, cnt, mine, sp = 0u;
    for (;;) {
        sum = 0u; cnt = 0u; mine = 0u;
#pragma unroll
        for (unsigned j = 0; j < 16; ++j) { const unsigned c = xb_ld(&bar[XB_XCNT(j)]); sum += c; cnt += (c > 0u) ? 1u : 0u; mine = (j == x) ? c : mine; }
        if (sum == G) break;
        __builtin_amdgcn_s_sleep(1);
        if ((++sp & 255u) == 0u) { if (xb_ld(&bar[XB_TMO])) break; if (sp > XB_SPIN_CAP) { atomicAdd(&bar[XB_TMO], 1u); break; } }
    }
    nloc = mine > 0u ? mine : 1u; nx = cnt > 0u ? cnt : 1u;
}
__device__ __forceinline__ void xcd_barrier(const XcdBarrier& b) {
    asm volatile("s_waitcnt vmcnt(0)" ::: "memory");
    __syncthreads();
    if (threadIdx.x == 0) {
        unsigned* bar = b.bar;
        __builtin_amdgcn_s_waitcnt(0);
        unsigned nloc = b.st[0], nx = b.st[1];
        if (nloc == 0u) { xcd_barrier_complete(bar, b.x, nloc, nx); b.st[0] = nloc; b.st[1] = nx; }
        const unsigned old = xb_add(&bar[XB_XSUB(b.x)], 1u);
        const unsigned gen = old / nloc;
        if (old + 1u == (gen + 1u) * nloc) {
            __builtin_amdgcn_fence(__ATOMIC_RELEASE, "agent");
            asm volatile("s_waitcnt vmcnt(0)" ::: "memory");
            const unsigned og = xb_add(&bar[XB_TOP], 1u);
            const unsigned tg = og / nx;
            if (og + 1u == (tg + 1u) * nx) xb_add(&bar[XB_TOPGEN], 1u);
            else XB_SPIN(xb_ld(&bar[XB_TOPGEN]) == tg, bar);
            __builtin_amdgcn_fence(__ATOMIC_ACQUIRE, "agent");
            xb_add(&bar[XB_XGEN(b.x)], 1u);
            asm volatile("s_waitcnt vmcnt(0)" ::: "memory");
        } else {
            XB_SPIN(xb_ld(&bar[XB_XGEN(b.x)]) == gen, bar);
            __builtin_amdgcn_fence(__ATOMIC_ACQUIRE, "agent");
            asm volatile("s_waitcnt vmcnt(0)" ::: "memory");
        }
    }
    __syncthreads();
}

struct Args { const void* in[26]; float* out; unsigned char* ws; int ph_lo, ph_hi; };
struct Ctx {
    LAS unsigned char* lds; int tid, lane, wave, vcu, G;
    const Args* a; unsigned char* ws; unsigned char* ob;
};
#define INF(i) ((const float*)A.in[i])

__device__ __forceinline__ float wave_sum(float v, int lane) {
#pragma unroll
    for (int o = 1; o < 64; o <<= 1) v += __int_as_float(__builtin_amdgcn_ds_bpermute((lane ^ o) << 2, __float_as_int(v)));
    return v;
}
__device__ __forceinline__ unsigned pk2(float lo, float hi) { return pg8::cvt_pk(lo, hi); }

__device__ __forceinline__ void conv_item(const float* src, int ldsrc, int n0s, int nvalid, int k0, const float* g, bf16* dst, int lddst, int n0d, LAS float* scr, int lane) {
    const int n = lane & 31;
#pragma unroll 8
    for (int i = 0; i < 32; ++i) { const int kk = 2 * i + (lane >> 5); float v = 0.f; if (n < nvalid) v = src[(size_t)(k0 + kk) * ldsrc + n0s + n]; if (g) v *= g[k0 + kk]; scr[kk * 33 + n] = v; }
    LDS_WAIT(); asm volatile("" ::: "memory");
    const int c = lane & 7;
#pragma unroll
    for (int j = 0; j < 4; ++j) { const int nn = (lane >> 3) + 8 * j; const LAS float* s = scr + (8 * c) * 33 + nn;
        v4u o; o.x = pk2(s[0 * 33], s[1 * 33]); o.y = pk2(s[2 * 33], s[3 * 33]); o.z = pk2(s[4 * 33], s[5 * 33]); o.w = pk2(s[6 * 33], s[7 * 33]);
        *(GAS v4u*)(dst + (size_t)(n0d + nn) * lddst + k0 + 8 * c) = o; }
    LDS_WAIT(); asm volatile("" ::: "memory");
}
__device__ __forceinline__ void conv_item_f8(const float* src, int ldsrc, int n0s, int k0, const float* g, float sc, unsigned char* dst, int lddst, int n0d, LAS float* scr, int lane) {
    const int n = lane & 31;
#pragma unroll 8
    for (int i = 0; i < 32; ++i) { const int kk = 2 * i + (lane >> 5); float v = src[(size_t)(k0 + kk) * ldsrc + n0s + n] * sc; if (g) v *= g[k0 + kk]; scr[kk * 33 + n] = v; }
    LDS_WAIT(); asm volatile("" ::: "memory");
    const int c = lane & 3;
#pragma unroll
    for (int j = 0; j < 2; ++j) { const int nn = (lane >> 2) + 16 * j; const LAS float* s = scr + (16 * c) * 33 + nn;
        v4u o; o.x = pg8::pk_fp8x4(s[0 * 33], s[1 * 33], s[2 * 33], s[3 * 33]); o.y = pg8::pk_fp8x4(s[4 * 33], s[5 * 33], s[6 * 33], s[7 * 33]);
        o.z = pg8::pk_fp8x4(s[8 * 33], s[9 * 33], s[10 * 33], s[11 * 33]); o.w = pg8::pk_fp8x4(s[12 * 33], s[13 * 33], s[14 * 33], s[15 * 33]);
        *(GAS v4u*)(dst + (size_t)(n0d + nn) * lddst + k0 + 16 * c) = o; }
    LDS_WAIT(); asm volatile("" ::: "memory");
}
struct ConvJob { const float* src; const float* src2; const float* g; bf16* dst; int ldsrc, nsrc, K, Ndst, mode, nb0; };
__device__ __forceinline__ void conv_job(const ConvJob& J, int& off, int gw, int NGW, LAS float* scr, int lane) {
    const int nblk = J.Ndst / 32 - J.nb0, n = (J.K / 64) * nblk;
    for (int it = (gw + NGW - off) % NGW; it < n; it += NGW) {
        const int kb = it / nblk, nb = J.nb0 + it % nblk, n0d = 32 * nb;
        if (J.mode == 1) { const int j = n0d >> 8, w = n0d & 255; const long dsel = (w < 128) ? 0l : (long)(J.src2 - J.src); conv_item(J.src + dsel, J.ldsrc, j * 128 + (w & 127), 32, 64 * kb, J.g, J.dst, J.K, n0d, scr, lane); }
        else { int nv = J.nsrc - n0d; nv = nv < 0 ? 0 : (nv > 32 ? 32 : nv); conv_item(J.src, J.ldsrc, n0d, nv, 64 * kb, J.g, J.dst, J.K, n0d, scr, lane); }
    }
    off = (off + n) % NGW;
}

template <bool F8> __device__ __forceinline__ void conv_tile(const float* sA, const float* sB, int ldsrc, int k0, const float* g, float sc, unsigned char* dst, int lddst, int n0d, LAS float* tile, int tid) {
    const int lane = tid & 63, wave = tid >> 6;
    const float* sp = (lane < 32 ? sA : sB) + 4 * (lane & 31);
#pragma unroll
    for (int i = 0; i < 8; ++i) { const int kk = wave + 8 * i; f32x4 v = *(const GAS f32x4*)(sp + (size_t)(k0 + kk) * ldsrc); const float gg = (g ? g[k0 + kk] : 1.f) * sc;
        *(LAS f32x4*)(tile + kk * 260 + 4 * lane) = v * gg; }
    __syncthreads();
    const int n = tid >> 1, half = tid & 1; const LAS float* tp = tile + (32 * half) * 260 + n;
    if constexpr (F8) {
    v4u o0, o1;
    o0.x = pg8::pk_fp8x4(tp[0 * 260], tp[1 * 260], tp[2 * 260], tp[3 * 260]);     o0.y = pg8::pk_fp8x4(tp[4 * 260], tp[5 * 260], tp[6 * 260], tp[7 * 260]);
    o0.z = pg8::pk_fp8x4(tp[8 * 260], tp[9 * 260], tp[10 * 260], tp[11 * 260]);   o0.w = pg8::pk_fp8x4(tp[12 * 260], tp[13 * 260], tp[14 * 260], tp[15 * 260]);
    o1.x = pg8::pk_fp8x4(tp[16 * 260], tp[17 * 260], tp[18 * 260], tp[19 * 260]); o1.y = pg8::pk_fp8x4(tp[20 * 260], tp[21 * 260], tp[22 * 260], tp[23 * 260]);
    o1.z = pg8::pk_fp8x4(tp[24 * 260], tp[25 * 260], tp[26 * 260], tp[27 * 260]); o1.w = pg8::pk_fp8x4(tp[28 * 260], tp[29 * 260], tp[30 * 260], tp[31 * 260]);
    GAS v4u* dp = (GAS v4u*)(dst + (size_t)(n0d + n) * lddst + k0 + 32 * half);
    dp[0] = o0; dp[1] = o1;
    } else {
    GAS v4u* dp = (GAS v4u*)(dst + (size_t)(n0d + n) * lddst + (k0 + 32 * half) * 2);
#pragma unroll
    for (int q = 0; q < 4; ++q) { const LAS float* t8 = tp + (8 * q) * 260;
        v4u o; o.x = pk2(t8[0 * 260], t8[1 * 260]); o.y = pk2(t8[2 * 260], t8[3 * 260]); o.z = pk2(t8[4 * 260], t8[5 * 260]); o.w = pk2(t8[6 * 260], t8[7 * 260]); dp[q] = o; }
    }
    __syncthreads();
}
struct ConvArgs { const float* sA; const float* sB; int ldsrc, k0; const float* g; float sc; unsigned char* dst; int lddst, n0d; bool f8; };
struct ConvRegs { f32x4 v[8]; float gg[8]; };
__device__ __forceinline__ void conv_issue(ConvRegs& R, const ConvArgs& a, int tid) {
    const int lane = tid & 63, wave = tid >> 6; const long dAB = a.sB - a.sA; const float* sp = a.sA + (lane < 32 ? 0L : dAB) + 4 * (lane & 31);
#pragma unroll
    for (int i = 0; i < 8; ++i) { const int kk = wave + 8 * i; R.v[i] = *(const GAS f32x4*)(sp + (size_t)(a.k0 + kk) * a.ldsrc); R.gg[i] = a.g ? a.g[a.k0 + kk] : 1.f; }
}
__device__ __forceinline__ void conv_finish(const ConvRegs& R, const ConvArgs& a, LAS float* tile, int tid) {
    const int lane = tid & 63, wave = tid >> 6;
#pragma unroll
    for (int i = 0; i < 8; ++i) { const int kk = wave + 8 * i; *(LAS f32x4*)(tile + kk * 260 + 4 * lane) = R.v[i] * (R.gg[i] * a.sc); }
    __syncthreads();
    const int n = tid >> 1, half = tid & 1; const LAS float* tp = tile + (32 * half) * 260 + n;
    if (a.f8) {
    v4u o0, o1;
    o0.x = pg8::pk_fp8x4(tp[0 * 260], tp[1 * 260], tp[2 * 260], tp[3 * 260]);     o0.y = pg8::pk_fp8x4(tp[4 * 260], tp[5 * 260], tp[6 * 260], tp[7 * 260]);
    o0.z = pg8::pk_fp8x4(tp[8 * 260], tp[9 * 260], tp[10 * 260], tp[11 * 260]);   o0.w = pg8::pk_fp8x4(tp[12 * 260], tp[13 * 260], tp[14 * 260], tp[15 * 260]);
    o1.x = pg8::pk_fp8x4(tp[16 * 260], tp[17 * 260], tp[18 * 260], tp[19 * 260]); o1.y = pg8::pk_fp8x4(tp[20 * 260], tp[21 * 260], tp[22 * 260], tp[23 * 260]);
    o1.z = pg8::pk_fp8x4(tp[24 * 260], tp[25 * 260], tp[26 * 260], tp[27 * 260]); o1.w = pg8::pk_fp8x4(tp[28 * 260], tp[29 * 260], tp[30 * 260], tp[31 * 260]);
    GAS v4u* dp = (GAS v4u*)(a.dst + (size_t)(a.n0d + n) * a.lddst + a.k0 + 32 * half);
    dp[0] = o0; dp[1] = o1;
    } else {
    GAS v4u* dp = (GAS v4u*)(a.dst + (size_t)(a.n0d + n) * a.lddst + (a.k0 + 32 * half) * 2);
#pragma unroll
    for (int q = 0; q < 4; ++q) { const LAS float* t8 = tp + (8 * q) * 260;
        v4u o; o.x = pk2(t8[0 * 260], t8[1 * 260]); o.y = pk2(t8[2 * 260], t8[3 * 260]); o.z = pk2(t8[4 * 260], t8[5 * 260]); o.w = pk2(t8[6 * 260], t8[7 * 260]); dp[q] = o; }
    }
    __syncthreads();
}
#define CONV_PIPE(it0_, n_, step_, ARGS) do { int it_ = (it0_); const int n__ = (n_), st_ = (step_); if (it_ < n__) { ConvRegs R0_, R1_; { const ConvArgs a_ = ARGS(it_); conv_issue(R0_, a_, F.tid); } \
        for (; it_ < n__; it_ += 2 * st_) { \
            if (it_ + st_ < n__) { const ConvArgs a_ = ARGS(it_ + st_); conv_issue(R1_, a_, F.tid); } \
            { const ConvArgs a_ = ARGS(it_); conv_finish(R0_, a_, tile, F.tid); } \
            if (it_ + st_ < n__) { if (it_ + 2 * st_ < n__) { const ConvArgs a_ = ARGS(it_ + 2 * st_); conv_issue(R0_, a_, F.tid); } \
                { const ConvArgs a_ = ARGS(it_ + st_); conv_finish(R1_, a_, tile, F.tid); } } } } } while (0)
__device__ __forceinline__ void p0_prologue(Ctx& F) {
    const Args& A = *F.a;
    LAS float* scr = (LAS float*)(F.lds + F.wave * 16384);
    const int gw = F.vcu * NWAVES + F.wave, NGW = F.G * NWAVES;
    { bf16* H = (bf16*)(F.ws + WS_H); float* ssq = (float*)(F.ws + WS_SSQ); const float* x = INF(0);
      for (int m0 = gw * 4; m0 < T; m0 += NGW * 4) {
          f32x4 v[4][4]; float ss[4] = {0.f, 0.f, 0.f, 0.f};
#pragma unroll
          for (int r = 0; r < 4; ++r) { const GAS f32x4* xr = (const GAS f32x4*)(x + (size_t)(m0 + r) * DM) + F.lane;
#pragma unroll
              for (int j = 0; j < 4; ++j) v[r][j] = xr[64 * j]; }
#pragma unroll
          for (int r = 0; r < 4; ++r) { GAS unsigned long long* o8 = (GAS unsigned long long*)(H + (size_t)(m0 + r) * DM) + F.lane;
#pragma unroll
              for (int j = 0; j < 4; ++j) { const unsigned a = pk2(v[r][j].x, v[r][j].y), b = pk2(v[r][j].z, v[r][j].w); o8[64 * j] = (unsigned long long)a | ((unsigned long long)b << 32);
                  ss[r] += pg8::bf_lo(a) * pg8::bf_lo(a) + pg8::bf_hi(a) * pg8::bf_hi(a) + pg8::bf_lo(b) * pg8::bf_lo(b) + pg8::bf_hi(b) * pg8::bf_hi(b); } }
          ss[0] = wave_sum(ss[0], F.lane); ss[1] = wave_sum(ss[1], F.lane); ss[2] = wave_sum(ss[2], F.lane); ss[3] = wave_sum(ss[3], F.lane);
#pragma unroll
          for (int r = 0; r < 4; ++r) if (F.lane < 16) ssq[(size_t)(m0 + r) * 16 + F.lane] = F.lane == 0 ? ss[r] : 0.f; } }
    { float* cs = (float*)(F.ws + WS_COS); float* sn = (float*)(F.ws + WS_SIN); const int* pos = (const int*)A.in[2];
      for (int idx = (F.vcu * NWAVES * 64) + F.tid; idx < T * 8; idx += F.G * NWAVES * 64) { const int t = idx >> 3, i = idx & 7;
          const float inv = (float)pow(500000.0, -(double)i / 8.0); const float ang = (float)pos[t] * inv; float s, c; sincosf(ang, &s, &c); cs[idx] = c; sn[idx] = s; } }
    { bf16* MN = (bf16*)(F.ws + WS_MEMN); const float* mem = INF(1); const float* g = INF(13);
      for (int m = gw; m < NB * NMEM; m += NGW) { const GAS f32x4* xr = (const GAS f32x4*)(mem + (size_t)m * DM) + F.lane; f32x4 v[4]; float ss = 0.f;
#pragma unroll
          for (int j = 0; j < 4; ++j) { v[j] = xr[64 * j]; ss += (v[j].x * v[j].x + v[j].y * v[j].y) + (v[j].z * v[j].z + v[j].w * v[j].w); }
          const float rs = rsqrtf(wave_sum(ss, F.lane) * (1.f / DM) + EPS);
#pragma unroll
          for (int l = 0; l < DEPTH; ++l) { GAS unsigned long long* o8 = (GAS unsigned long long*)(MN + ((size_t)l * NB * NMEM + m) * DM) + F.lane;
#pragma unroll
              for (int j = 0; j < 4; ++j) { const f32x4 gg = *((const GAS f32x4*)(g + l * DM) + F.lane + 64 * j);
                  o8[64 * j] = (unsigned long long)pk2(v[j].x * rs * gg.x, v[j].y * rs * gg.y) | ((unsigned long long)pk2(v[j].z * rs * gg.z, v[j].w * rs * gg.w) << 32); } } } }
    { bf16* WQ = (bf16*)(F.ws + WS_WMQ); const float* w = INF(14); const float* g = INF(12);
      for (int i8 = (F.vcu * NWAVES * 64) + F.tid; i8 < DEPTH * DM * DM / 8; i8 += F.G * NWAVES * 64) { const int row = i8 / (DM / 8);
          const f32x4 a = *(const GAS f32x4*)(w + (size_t)i8 * 8), b = *(const GAS f32x4*)(w + (size_t)i8 * 8 + 4); const float gg = g[row];
          v4u o; o.x = pk2(a.x * gg, a.y * gg); o.y = pk2(a.z * gg, a.w * gg); o.z = pk2(b.x * gg, b.y * gg); o.w = pk2(b.z * gg, b.w * gg);
          *(GAS v4u*)(WQ + (size_t)i8 * 8) = o; } }
    { LAS float* tile = (LAS float*)(F.lds);
      auto dense_args = [&](int idx) -> ConvArgs {
          ConvArgs a;
          if (idx < DEPTH * 448) { const int l = idx / 448, r = idx % 448;
              if (r < 192) { const int kb = r / 12, j = r % 12; const float* w = INF(4) + (size_t)l * DM * D_IN + j * 256;
                  a = ConvArgs{w, w + 128, D_IN, 64 * kb, INF(3) + l * DM, 1.f, F.ws + WS_WIN + (size_t)l * D_INP * DM * 2, DM * 2, j * 256, false}; }
              else if (r < 256) { const int r2 = r - 192, kb = r2 / 4, j = r2 % 4; const float* w = INF(11) + (size_t)l * DM * DM + j * 256;
                  a = ConvArgs{w, w + 128, DM, 64 * kb, nullptr, 1.f, F.ws + WS_WOUT + (size_t)l * DM * DM * 2, DM * 2, j * 256, false}; }
              else if (r < 384) { const int r2 = r - 256, kb = r2 / 8, j = r2 % 8; const float* w = INF(15) + (size_t)l * DM * 2 * DM + j * 256;
                  a = ConvArgs{w, w + 128, 2 * DM, 64 * kb, nullptr, 1.f, F.ws + WS_WMKV + (size_t)l * 2 * DM * DM * 2, DM * 2, j * 256, false}; }
              else { const int r2 = r - 384, kb = r2 / 4, j = r2 % 4; const float* w = INF(16) + (size_t)l * DM * DM + j * 256;
                  a = ConvArgs{w, w + 128, DM, 64 * kb, nullptr, 1.f, F.ws + WS_WMO + (size_t)l * DM * DM * 2, DM * 2, j * 256, false}; } }
          else { const int x2 = idx - DEPTH * 448, i = x2 / 528, r = x2 % 528; const bool f8 = (MK_DENSE8 >> i) & 1;
              unsigned char* d13 = F.ws + WS_WFF13 + (size_t)i * 2 * D_FF * DM * 2; unsigned char* d2 = F.ws + WS_WFF2 + (size_t)i * DM * D_FF * 2;
              if (r < 352) { const int kb = r / 22, j = r % 22; const float* w1 = INF(18) + (size_t)i * DM * D_FF + j * 128; const float* w3 = INF(19) + (size_t)i * DM * D_FF + j * 128;
                  a = ConvArgs{w1, w3, D_FF, 64 * kb, INF(17) + (2 * i) * DM, f8 ? pg8::F8_W1 : 1.f, d13, f8 ? DM : DM * 2, j * 256, f8}; }
              else { const int r2 = r - 352, kb = r2 / 4, j = r2 % 4; const float* w2 = INF(20) + (size_t)i * D_FF * DM + j * 256;
                  a = ConvArgs{w2, w2 + 128, DM, 64 * kb, nullptr, f8 ? pg8::F8_W2 : 1.f, d2, f8 ? D_FF : D_FF * 2, j * 256, f8}; } }
          return a; };
      static_assert(2 * D_FF / 256 == 22 && D_FF / 64 == 44 && D_IN / 256 == 12, "flat tile list");
#define DENSE_ARGS(it) dense_args(it)
      CONV_PIPE(F.vcu, DEPTH * 448 + 2 * 528, F.G, DENSE_ARGS);
#undef DENSE_ARGS
    }
    int off = 0;
    for (int l = 0; l < DEPTH; ++l) { ConvJob J{INF(4) + (size_t)l * DM * D_IN, nullptr, INF(3) + l * DM, (bf16*)(F.ws + WS_WIN) + (size_t)l * D_INP * DM, D_IN, D_IN, DM, D_INP, 0, 96}; conv_job(J, off, gw, NGW, scr, F.lane); }
    for (int i = 0; i < 2; ++i) { ConvJob J{INF(21) + (size_t)i * DM * NEXP, nullptr, INF(17) + (2 * i + 1) * DM, (bf16*)(F.ws + WS_WRT) + (size_t)i * 256 * DM, NEXP, NEXP, DM, 256, 0, 0}; conv_job(J, off, gw, NGW, scr, F.lane); }
}
__device__ __forceinline__ void moe_weight_conv_f8(Ctx& F, int l) {
    const Args& A = *F.a; const int i = l >> 1;
    LAS float* tile = (LAS float*)(F.lds);
    constexpr int T13 = (DM / 64) * (2 * D_EXP / 256), T2 = (D_EXP / 64) * (DM / 256), TE = T13 + T2;
    auto moe_args = [&](int it) -> ConvArgs { const int e = it / TE, r = it % TE; ConvArgs a;
        if (r < T13) { const int kb = r / (2 * D_EXP / 256), j = r % (2 * D_EXP / 256); const size_t so = ((size_t)i * NEXP + e) * DM * D_EXP;
            a = ConvArgs{INF(22) + so + j * 128, INF(23) + so + j * 128, D_EXP, 64 * kb, INF(17) + l * DM, pg8::F8_W1, (unsigned char*)(F.ws + WS_WE13) + (size_t)e * 2 * D_EXP * DM, DM, j * 256, true}; }
        else { const int r2 = r - T13, kb = r2 / (DM / 256), j = r2 % (DM / 256); const float* sp = INF(24) + ((size_t)i * NEXP + e) * D_EXP * DM + j * 256;
            a = ConvArgs{sp, sp + 128, DM, 64 * kb, nullptr, pg8::F8_W2, (unsigned char*)(F.ws + WS_WE2) + (size_t)e * DM * D_EXP, D_EXP, j * 256, true}; }
        return a; };
#define MOE_ARGS(it) moe_args(it)
    CONV_PIPE(F.vcu, NEXP * TE, F.G, MOE_ARGS);
#undef MOE_ARGS
}
__device__ __forceinline__ void h_to_fp8(Ctx& F) {
    const bf16* H = (const bf16*)(F.ws + WS_H); unsigned char* H8 = (unsigned char*)(F.ws + WS_H8);
    const int gw = F.vcu * NWAVES + F.wave, NGW = F.G * NWAVES;
    for (int m = gw; m < T; m += NGW) { const GAS v4u* hr = (const GAS v4u*)(H + (size_t)m * DM) + 2 * F.lane; const v4u a = hr[0], b = hr[1];
        v4u o; o.x = pg8::pk_fp8x4(pg8::bf_lo(a.x), pg8::bf_hi(a.x), pg8::bf_lo(a.y), pg8::bf_hi(a.y)); o.y = pg8::pk_fp8x4(pg8::bf_lo(a.z), pg8::bf_hi(a.z), pg8::bf_lo(a.w), pg8::bf_hi(a.w));
        o.z = pg8::pk_fp8x4(pg8::bf_lo(b.x), pg8::bf_hi(b.x), pg8::bf_lo(b.y), pg8::bf_hi(b.y)); o.w = pg8::pk_fp8x4(pg8::bf_lo(b.z), pg8::bf_hi(b.z), pg8::bf_lo(b.w), pg8::bf_hi(b.w));
        *((GAS v4u*)(H8 + (size_t)m * DM) + F.lane) = o; }
}
__device__ __forceinline__ void scan_phase(Ctx& F) {
    const float* logf = (const float*)(F.ws + WS_LOGF); float* cs2 = (float*)(F.ws + WS_CS2);
    LAS float* part = (LAS float*)(F.lds);
    for (int w = blockIdx.x; w < NB * 8; w += F.G) { const int b = w >> 3, hh = w & 7;
        float v[16]; float s = 0.f;
#pragma unroll
        for (int k = 0; k < 16; ++k) { s += logf[((size_t)b * SEQ + F.tid * 16 + k) * 8 + hh]; v[k] = s; }
        float incl = s;
#pragma unroll
        for (int o = 1; o < 64; o <<= 1) { const float y = __shfl_up(incl, o); if (F.lane >= o) incl += y; }
        if (F.lane == 63) part[F.wave] = incl;
        __syncthreads();
        float base = incl - s;
        for (int k = 0; k < F.wave; ++k) base += part[k];
        __syncthreads();
        float* op = cs2 + ((size_t)b * 8 + hh) * SEQ + F.tid * 16;
#pragma unroll
        for (int k = 0; k < 16; k += 4) *(f32x4*)(op + k) = (f32x4){-(base + v[k]) * LOG2E, -(base + v[k + 1]) * LOG2E, -(base + v[k + 2]) * LOG2E, -(base + v[k + 3]) * LOG2E};
    }
}
__device__ __forceinline__ void combine_phase(Ctx& F, int l) {
    const Args& A = *F.a;
    const float lam_init = 0.8f - 0.6f * expf(-0.3f * (float)l);
    const float d1 = wave_sum(INF(5)[l * 64 + F.lane] * INF(6)[l * 64 + F.lane], F.lane), d2 = wave_sum(INF(7)[l * 64 + F.lane] * INF(8)[l * 64 + F.lane], F.lane);
    const float lam = expf(d1) - expf(d2) + lam_init, post = 1.f - lam_init;
    const bf16* O1 = (const bf16*)(F.ob + OUT_O1); const bf16* O2 = (const bf16*)(F.ob + OUT_O2); bf16* MX = (bf16*)(F.ob + OUT_MIX);
    const float* g = INF(9) + l * 128 + (8 * F.lane & 127);
    const f32x4 g0 = *(const f32x4*)g, g1 = *(const f32x4*)(g + 4);
    const int gw = F.vcu * NWAVES + F.wave, NGW = F.G * NWAVES;
    for (int m = gw; m < T; m += NGW) {
        const v4u a = *(const GAS v4u*)(O1 + (size_t)m * 512 + 8 * F.lane), b = *(const GAS v4u*)(O2 + (size_t)m * 512 + 8 * F.lane);
        float d[8];
        d[0] = pg8::bf_lo(a.x) - lam * pg8::bf_lo(b.x); d[1] = pg8::bf_hi(a.x) - lam * pg8::bf_hi(b.x); d[2] = pg8::bf_lo(a.y) - lam * pg8::bf_lo(b.y); d[3] = pg8::bf_hi(a.y) - lam * pg8::bf_hi(b.y);
        d[4] = pg8::bf_lo(a.z) - lam * pg8::bf_lo(b.z); d[5] = pg8::bf_hi(a.z) - lam * pg8::bf_hi(b.z); d[6] = pg8::bf_lo(a.w) - lam * pg8::bf_lo(b.w); d[7] = pg8::bf_hi(a.w) - lam * pg8::bf_hi(b.w);
        float ss = 0.f;
#pragma unroll
        for (int k = 0; k < 8; ++k) ss += d[k] * d[k];
        ss += __shfl_xor(ss, 1); ss += __shfl_xor(ss, 2); ss += __shfl_xor(ss, 4); ss += __shfl_xor(ss, 8);
        const float r = rsqrtf(ss * (1.f / 128.f) + SUBLN_EPS) * post;
        v4u o; o.x = pk2(d[0] * r * g0[0], d[1] * r * g0[1]); o.y = pk2(d[2] * r * g0[2], d[3] * r * g0[3]); o.z = pk2(d[4] * r * g1[0], d[5] * r * g1[1]); o.w = pk2(d[6] * r * g1[2], d[7] * r * g1[3]);
        *(GAS v4u*)(MX + (size_t)m * DM + 8 * F.lane) = o;
    }
}
__device__ __forceinline__ void route_assign(Ctx& F) {
    const int* choice = (const int*)(F.ws + RT_CHOICE); const float* gates = (const float*)(F.ws + RT_GATES); const int* cnt = (const int*)(F.ws + RT_CNT);
    int* tok = (int*)(F.ws + RT_TOK); float* gate_s = (float*)(F.ws + RT_GATE_S); int* texp = (int*)(F.ws + RT_TEXP); int* ntl = (int*)(F.ws + RT_NT);
    LAS int* L = (LAS int*)(F.lds);
    for (int w = blockIdx.x; w < T / 256; w += F.G) {
        { const int e16 = F.tid & 15, ch = F.tid >> 4; int tot = 0, pre = 0;
          for (int k = 0; k < 8; ++k) { const int pm = ch * 8 + k; const int c = cnt[pm * 16 + e16]; tot += c; if (pm < w) pre += c; }
          L[ch * 16 + e16] = tot; L[512 + ch * 16 + e16] = pre; }
        __syncthreads();
        if (F.tid < 16) { int tot = 0, pre = 0; for (int ch = 0; ch < 32; ++ch) { tot += L[ch * 16 + F.tid]; pre += L[512 + ch * 16 + F.tid]; } L[1024 + F.tid] = tot; L[1040 + F.tid] = pre; L[1072 + F.tid] = 0; }
        __syncthreads();
        if (F.tid < 2) { int run = 0; for (int e = 0; e < 8; ++e) { L[1056 + F.tid * 8 + e] = run; run += ((L[1024 + F.tid * 8 + e] + 255) >> 8) << 8; } if (w == 0) ntl[F.tid] = run >> 8; }
        __syncthreads();
        int ch = 0, rk[2] = {0, 0};
        if (F.tid < 256) { ch = choice[w * 256 + F.tid];
            for (int idx = 0; idx < 16; ++idx) { const int s = idx >> 3; const bool mine = ((ch >> (8 * s)) & 255) == (idx & 7);
                const unsigned long long mk = __ballot(mine); if (mine) rk[s] = __popcll(mk & ((1ull << F.lane) - 1ull)); if (F.lane == 0) L[1088 + F.wave * 16 + idx] = __popcll(mk); } }
        __syncthreads();
        if (F.tid < 256) { const int t = w * 256 + F.tid;
#pragma unroll
            for (int s = 0; s < 2; ++s) { const int e = (ch >> (8 * s)) & 255; const int idx = s * 8 + e; int r = rk[s];
                for (int k = 0; k < F.wave; ++k) r += L[1088 + k * 16 + idx];
                const int slot = L[1056 + idx] + L[1040 + idx] + r; tok[s * MOE_ROWS + slot] = t; gate_s[s * MOE_ROWS + slot] = gates[(size_t)t * 2 + s]; } }
        if (w == 0) { for (int idx = F.tid; idx < 2 * 272; idx += NWAVES * 64) { const int s = idx / 272, tile = idx % 272; int ee = 0;
                for (int e = 0; e < 8; ++e) if ((L[1056 + s * 8 + e] >> 8) <= tile) ee = e;
                texp[s * 272 + tile] = ee; } }
        __syncthreads();
    }
}
struct SchedCross {
    const char* A; const char* B; char* O; int mode, G, c;
    __device__ __forceinline__ bool next(int i, pg8::Unit& u) const {
        if (!pg8::tile_order(i, G, c, T / 256, 4, u.pm, u.pn)) return false;
        const size_t t = ((size_t)u.pm * 256 * DM + (size_t)u.pn * 256) * 2; u.a = A + t; u.o = O + t; u.aux = u.pm * 256; u.ridx = nullptr;
        u.b = mode == 0 ? B + ((size_t)(u.pm >> 5) * 256 * DM + (size_t)u.pn * 256) * 2 : B + ((size_t)u.pn * 256 * (NB * NMEM) + (size_t)(u.pm >> 5) * 256) * 2; return true; }
};
struct SchedKV {
    unsigned char* ws; int G, c;
    __device__ __forceinline__ bool next(int i, pg8::Unit& u) const {
        const long L = (long)i * G + c; if (L >= 256) return false;
        const int l = (int)L >> 6, rem = (int)L & 63; const char* mn = (const char*)(ws + WS_MEMN) + (size_t)l * NB * NMEM * DM * 2; const char* w = (const char*)(ws + WS_WMKV) + (size_t)l * 2 * DM * DM * 2;
        u.aux = 0; u.ridx = nullptr;
        if (rem < 32) { u.pm = rem >> 2; u.pn = rem & 3; u.a = mn + (size_t)u.pm * 256 * DM * 2; u.b = w + (size_t)u.pn * 256 * DM * 2;
            u.o = (char*)(ws + WS_KM) + ((size_t)l * NB * NMEM * DM + (size_t)u.pm * 256 * DM + u.pn * 256) * 2; u.aux = DM; }
        else { const int r2 = rem - 32; u.pm = r2 >> 2; u.pn = r2 & 3; u.a = mn + (size_t)u.pm * 256 * DM * 2; u.b = w + (size_t)(DM + u.pn * 256) * DM * 2;
            u.o = (char*)(ws + WS_VT) + ((size_t)l * NB * NMEM * DM + (size_t)u.pm * 256 * DM + u.pn * 256) * 2; u.aux = DM; }
        return true; }
};
struct SchedXF {
    unsigned char* ws; int l, G, c, osz;
    __device__ __forceinline__ bool next(int i, pg8::Unit& u) const {
        const long L = (long)i * G + c; if (L >= 256) return false;
        const int r = (int)L & 127, b = r >> 4, h = (r >> 2) & 3, q4 = r & 3; u.pm = 0; u.pn = 0; u.aux = DM; u.ridx = nullptr;
        const size_t lm = (size_t)l * NB * NMEM * DM, lw = (size_t)l * DM * DM;
        if (L < 128) { u.a = (const char*)(ws + WS_KM) + (lm + (size_t)b * 256 * DM + h * 256) * 2; u.b = (const char*)(ws + WS_WMQ) + (lw + (size_t)q4 * 256 * DM + h * 256) * 2;
            u.o = (char*)(ws + WS_MT) + ((size_t)b * DM * DM + (size_t)h * 256 * DM + q4 * 256) * osz; }
        else { u.a = (const char*)(ws + WS_WMO) + (lw + (size_t)q4 * 256 * DM + h * 256) * 2; u.b = (const char*)(ws + WS_VT) + (lm + (size_t)b * 256 * DM + h * 256) * 2;
            u.o = (char*)(ws + WS_VWT) + ((size_t)b * DM * DM + (size_t)q4 * 256 * DM + h * 256) * osz; }
        return true; }
};
struct SchedCrossF {
    const char* A; const char* B; char* O; int G, c, esz, osz;
    __device__ __forceinline__ bool next(int i, pg8::Unit& u) const {
        if (!pg8::tile_order(i, G, c, T / 256, 4, u.pm, u.pn)) return false;
        u.a = A + (size_t)u.pm * 256 * DM * esz; u.b = B + ((size_t)(u.pm >> 5) * DM * DM + (size_t)u.pn * 256 * DM) * esz;
        u.o = O ? O + ((size_t)u.pm * 256 * DM + (size_t)u.pn * 256) * osz : nullptr; u.aux = u.pm * 256; u.ridx = nullptr; return true; }
};
struct SchedMoE {
    unsigned char* ws; const LAS int* texp; const int* tok; int nT, up, G, c, f8; size_t uoff; int rot;
    static constexpr int MSKIP = 4;
    __device__ __forceinline__ bool next(int i, pg8::Unit& u) const {
        long L;
        if (rot == 0) L = (long)i * G + c;
        else { const int rd = c < rot ? i + MSKIP : i; L = rd < MSKIP ? (long)rd * (G - rot) + (c - rot) : (long)MSKIP * (G - rot) + (long)(rd - MSKIP) * G + c; }
        if (!pg8::tile_of(L, nT, up ? 28 : 4, u.pm, u.pn)) return false;
        const int e = __builtin_amdgcn_readfirstlane(texp[u.pm]); u.aux = u.pm * 256; u.o = nullptr;
        const size_t eb = f8 ? 1 : 2;
        if (up) { u.a = (const char*)(ws + (f8 ? WS_H8 : WS_H)); u.ridx = tok + u.pm * 256; u.b = (const char*)(ws + WS_WE13) + ((size_t)e * 2 * D_EXP + (size_t)u.pn * 256) * DM * eb; }
        else { u.a = (const char*)(ws + WS_R) + uoff + (size_t)u.pm * 256 * D_EXP * eb; u.ridx = nullptr; u.b = (const char*)(ws + WS_WE2) + ((size_t)e * DM + (size_t)u.pn * 256) * D_EXP * eb; }
        return true; }
};

#ifndef MK_MULTI
#define MK_MULTI 0
#endif
__global__ void __launch_bounds__(NWAVES * 64, 2) fwd(Args args) {
    extern __shared__ __attribute__((aligned(16))) unsigned char lds[];
    Ctx F;
    F.lds = (LAS unsigned char*)lds; F.tid = threadIdx.x; F.lane = F.tid & 63; F.wave = __builtin_amdgcn_readfirstlane(F.tid >> 6);
    F.G = gridDim.x; { const int bx = blockIdx.x; F.vcu = (F.G % 8 == 0) ? (bx % 8) * (F.G / 8) + bx / 8 : bx; }
    F.a = &args; F.ws = args.ws; F.ob = (unsigned char*)args.out;
    const Args& A = args;
    unsigned char* ws = args.ws;
    for (int u = F.tid; u < (LDS_BYTES - LDSCTL_OFF) / 4; u += NWAVES * 64) ((LAS unsigned*)(F.lds + LDSCTL_OFF))[u] = 0u;
    __syncthreads();
    volatile LAS unsigned* MISC = (volatile LAS unsigned*)(F.lds + MISC_OFF);
    XcdBarrier bar = xcd_barrier_post((unsigned*)(ws + WS_CTL) + CW_BAR, MISC + 8);
    const int lo = args.ph_lo, hi = args.ph_hi; int ph = 0;
#ifndef MK_MASK
#define MK_MASK 0xFFFFFFFFu
#endif
#define EN(k) (((MK_MASK) >> (k)) & 1u)
#define PH_ON (ph >= lo && ph < hi)
#define PH_END do { if (ph >= lo && ph + 1 < hi) xcd_barrier(bar); ++ph; } while (0)
    LAS unsigned char* ring = F.lds;
    const int bx0 = (int)blockIdx.x; unsigned char* const ws0 = ws;
    const size_t TILE_D = (size_t)256 * DM * 2;
#define PH_LOCALS int bx = bx0; unsigned char* ws = ws0; asm volatile("" : "+s"(bx), "+s"(ws)); \
    float* ssq_mix = (float*)(ws + WS_SSQ); float* ssq_mem = ssq_mix + (size_t)T * 16; float* ssq_ffn = ssq_mix + (size_t)2 * T * 16; bf16* H = (bf16*)(ws + WS_H); \
    Ctx Fl = F; Fl.ws = ws; Fl.tid = (int)threadIdx.x; asm volatile("" : "+v"(Fl.tid)); Fl.lane = Fl.tid & 63; Fl.wave = __builtin_amdgcn_readfirstlane(Fl.tid >> 6); asm volatile("" : "+s"(Fl.vcu), "+s"(Fl.G)); \
    const __attribute__((address_space(4))) Args* ap_ = (const __attribute__((address_space(4))) Args*)__builtin_amdgcn_kernarg_segment_ptr(); asm volatile("" : "+s"(ap_)); \
    Args A_; _Pragma("unroll") for (int i_ = 0; i_ < 26; ++i_) A_.in[i_] = ap_->in[i_]; A_.out = ap_->out; A_.ws = ap_->ws; A_.ph_lo = ap_->ph_lo; A_.ph_hi = ap_->ph_hi; Fl.a = &A_; const Args& A = A_; (void)A; \
    (void)ssq_mix; (void)ssq_mem; (void)ssq_ffn; (void)H; (void)bx;

    if (PH_ON && EN(0)) { PH_LOCALS p0_prologue(Fl); }
    PH_END;
    if (PH_ON && EN(1)) { PH_LOCALS SchedKV S{ws, Fl.G, bx}; pg8::EpiPlain<false, DM> E{nullptr, 1.f}; pg8::gemm_phase<pg8::EpiPlain<false, DM>, SchedKV, false>(ring, pg8::Gemm{DM, DM, DM}, S, E, (LAS float*)(Fl.lds + LDSR_OFF)); }
    PH_END;

    for (int l = 0; l < DEPTH; ++l) {
        const bool dense8 = ((l & 1) == 0) && ((MK_DENSE8 >> (l >> 1)) & 1), need_h8 = (l & 1) || dense8;
        if (PH_ON && EN(2)) { PH_LOCALS
            pg8::SchedDense S{(const char*)H, (const char*)(ws + WS_WIN) + (size_t)l * D_INP * DM * 2, nullptr, TILE_D, TILE_D, 0, T / 256, D_INP / 256, Fl.G, bx};
            pg8::EpiIn E{(bf16*)(ws + WS_R), ssq_mix, (const float*)(ws + WS_COS), (const float*)(ws + WS_SIN), (float*)(ws + WS_LOGF), INF(10) + l * 8, (unsigned*)(ws + WS_CTL) + CW_KMX + l * 128};
            pg8::gemm_phase<pg8::EpiIn, pg8::SchedDense, false>(ring, pg8::Gemm{DM, DM, DM}, S, E, (LAS float*)(Fl.lds + LDSR_OFF));
        }
        PH_END;
        if (PH_ON && EN(3)) { PH_LOCALS scan_phase(Fl); if (l & 1) moe_weight_conv_f8(Fl, l);
            __syncthreads();
            SchedXF S{ws, l, Fl.G, bx, 1}; pg8::EpiPlain8<DM> E{pg8::F8_X};
            pg8::gemm_phase<pg8::EpiPlain8<DM>, SchedXF, false>(ring, pg8::Gemm{DM, DM, 256}, S, E, (LAS float*)(Fl.lds + LDSR_OFF)); }
        PH_END;
        if (PH_ON && EN(4)) { PH_LOCALS
            const attn_body::bf16* QKV = (const attn_body::bf16*)(ws + WS_R);
            const int ngr = Fl.G / 8, g = Fl.vcu >> 3, s = Fl.vcu & 7;
            { const float lam_init = 0.8f - 0.6f * expf(-0.3f * (float)l);
              const float d1 = wave_sum(INF(5)[l * 64 + Fl.lane] * INF(6)[l * 64 + Fl.lane], Fl.lane), d2 = wave_sum(INF(7)[l * 64 + Fl.lane] * INF(8)[l * 64 + Fl.lane], Fl.lane);
              const float lam = expf(d1) - expf(d2) + lam_init, post = 1.f - lam_init;
              for (int p = g; p < NB * 4; p += ngr) { const int b = p >> 2, head = p & 3; const attn_body::bf16* base = QKV + (size_t)b * SEQ * QKVP;
                attn_body::bf16* O1 = (attn_body::bf16*)(Fl.ob + OUT_O1) + (size_t)b * SEQ * 512 + head * 128;
                attn_body::bf16* MX = (attn_body::bf16*)(Fl.ob + OUT_MIX) + (size_t)b * SEQ * DM + head * 128;
                for (int mi = 0; mi < 8; ++mi) { const int m = mi >> 2, i = mi & 3, qb = (i == 0) ? s : (i == 1) ? 15 - s : (i == 2) ? 16 + s : 31 - s;
                    attn_body::diff_unit2<8>(qb, base + m * 256 + head * 64, base + 512 + m * 256 + head * 64, base + 1024 + head * 128, m ? MX : O1, m ? DM : 512, m ? O1 : nullptr, lam, post, INF(9) + l * 128, (char*)lds); } } }
            for (int p = g; p < NB * 8; p += ngr) { const int b = p >> 3, jf = p & 7; const attn_body::bf16* base = QKV + (size_t)b * SEQ * QKVP;
                attn_body::bf16* O = (attn_body::bf16*)(Fl.ob + OUT_MIX) + (size_t)b * SEQ * DM + 512 + jf * 64;
                const float* bias = (const float*)(ws + WS_CS2) + ((size_t)b * 8 + jf) * SEQ;
                const unsigned* kmx = (const unsigned*)(ws + WS_CTL) + CW_KMX + l * 128 + b * 16 + jf * 2;
                const float kmaxn = __builtin_sqrtf(__uint_as_float(__builtin_amdgcn_readfirstlane(__hip_atomic_load(kmx, __ATOMIC_RELAXED, __HIP_MEMORY_SCOPE_AGENT))) + __uint_as_float(__builtin_amdgcn_readfirstlane(__hip_atomic_load(kmx + 1, __ATOMIC_RELAXED, __HIP_MEMORY_SCOPE_AGENT))));
                for (int i = 0; i < 4; ++i) { const int qb = (i == 0) ? s : (i == 1) ? 15 - s : (i == 2) ? 16 + s : 31 - s;
                    attn_body::fox_unit<8>(qb, base + 1536 + jf * 64, base + 2048 + jf * 64, base + 2560 + jf * 64, O, DM, bias, kmaxn, (char*)lds); } }
        }
        PH_END;
        if (PH_ON && EN(6)) { PH_LOCALS
            pg8::SchedDense S{(const char*)(Fl.ob + OUT_MIX), (const char*)(ws + WS_WOUT) + (size_t)l * DM * DM * 2, nullptr, TILE_D, TILE_D, 0, T / 256, 4, Fl.G, bx};
            pg8::EpiRes<false> E{H, ssq_mem, nullptr, nullptr, (unsigned char*)(ws + WS_H8), 1.f};
            pg8::gemm_phase<pg8::EpiRes<false>, pg8::SchedDense, false>(ring, pg8::Gemm{DM, DM, DM}, S, E, (LAS float*)(Fl.lds + LDSR_OFF));
        }
        PH_END;
        if (PH_ON && EN(7)) { PH_LOCALS
            SchedCrossF S{(const char*)(ws + WS_H8), (const char*)(ws + WS_MT), (char*)(ws + WS_R), Fl.G, bx, 1, 1};
            pg8::EpiSoftmax<true> E{(LAS float*)(Fl.lds + LDSX_OFF), ssq_mem, CM * (1.f / pg8::F8_X)};
            pg8::gemm_phase<pg8::EpiSoftmax<true>, SchedCrossF, false, true>(ring, pg8::Gemm{DM / 2, DM / 2, DM / 2}, S, E, (LAS float*)(Fl.lds + LDSR_OFF));
        }
        PH_END;
        if (PH_ON && EN(10)) { PH_LOCALS
            SchedCrossF S{(const char*)(ws + WS_R), (const char*)(ws + WS_VWT), nullptr, Fl.G, bx, 1, 1};
            pg8::EpiRes<false> E{H, ssq_ffn, nullptr, nullptr, need_h8 ? (unsigned char*)(ws + WS_H8) : nullptr, 1.f / (pg8::F8_P * pg8::F8_X)};
            pg8::gemm_phase<pg8::EpiRes<false>, SchedCrossF, false, true>(ring, pg8::Gemm{DM / 2, DM / 2, DM / 2}, S, E, (LAS float*)(Fl.lds + LDSR_OFF));
        }
        PH_END;
        if ((l & 1) == 0) {
            const int i = l >> 1;
            if (PH_ON && EN(11)) { PH_LOCALS
                if (dense8) {
                    pg8::SchedDense S{(const char*)(ws + WS_H8), (const char*)(ws + WS_WFF13) + (size_t)i * 2 * D_FF * DM * 2, nullptr, (size_t)256 * DM, (size_t)256 * DM, 0, T / 256, 2 * D_FF / 256, Fl.G, bx};
                    pg8::EpiSwiglu8<false, D_FF> E{(unsigned char*)(ws + WS_R), ssq_ffn, nullptr};
                    pg8::gemm_phase<pg8::EpiSwiglu8<false, D_FF>, pg8::SchedDense, false, true>(ring, pg8::Gemm{DM / 2, DM / 2, DM / 2}, S, E, (LAS float*)(Fl.lds + LDSR_OFF));
                } else {
                pg8::SchedDense S{(const char*)H, (const char*)(ws + WS_WFF13) + (size_t)i * 2 * D_FF * DM * 2, nullptr, TILE_D, TILE_D, 0, T / 256, 2 * D_FF / 256, Fl.G, bx};
                pg8::EpiSwiglu<false, D_FF> E{(bf16*)(ws + WS_R), ssq_ffn, nullptr};
                pg8::gemm_phase<pg8::EpiSwiglu<false, D_FF>, pg8::SchedDense, false>(ring, pg8::Gemm{DM, DM, DM}, S, E, (LAS float*)(Fl.lds + LDSR_OFF));
                }
            }
            PH_END;
            if (PH_ON && EN(12)) { PH_LOCALS
                if (dense8) {
                    pg8::SchedDense S{(const char*)(ws + WS_R), (const char*)(ws + WS_WFF2) + (size_t)i * DM * D_FF * 2, nullptr, (size_t)256 * D_FF, (size_t)256 * D_FF, 0, T / 256, 4, Fl.G, bx};
                    pg8::EpiRes<false> E{H, ssq_mix, nullptr, nullptr, nullptr, 1.f / (pg8::F8_W2 * pg8::F8_U)};
                    pg8::gemm_phase<pg8::EpiRes<false>, pg8::SchedDense, false, true>(ring, pg8::Gemm{D_FF / 2, D_FF / 2, D_FF / 2}, S, E, (LAS float*)(Fl.lds + LDSR_OFF));
                } else {
                pg8::SchedDense S{(const char*)(ws + WS_R), (const char*)(ws + WS_WFF2) + (size_t)i * DM * D_FF * 2, nullptr, (size_t)256 * D_FF * 2, (size_t)256 * D_FF * 2, 0, T / 256, 4, Fl.G, bx};
                pg8::EpiRes<false> E{H, ssq_mix, nullptr, nullptr, nullptr, 1.f};
                pg8::gemm_phase<pg8::EpiRes<false>, pg8::SchedDense, false>(ring, pg8::Gemm{D_FF, D_FF, D_FF}, S, E, (LAS float*)(Fl.lds + LDSR_OFF));
                }
            }
            PH_END;
        } else {
            const int i = l >> 1;
            if (PH_ON && EN(13)) { PH_LOCALS
                { int* tok = (int*)(ws + RT_TOK); for (int k = bx * NWAVES * 64 + Fl.tid; k < 2 * MOE_ROWS; k += Fl.G * NWAVES * 64) tok[k] = -1; }
                pg8::SchedDense S{(const char*)H, (const char*)(ws + WS_WRT) + (size_t)i * 256 * DM * 2, nullptr, TILE_D, TILE_D, 0, T / 256, 1, Fl.G, bx};
                pg8::EpiRouter E{ssq_ffn, (int*)(ws + RT_CHOICE), (float*)(ws + RT_GATES), (int*)(ws + RT_CNT), (LAS int*)(Fl.lds + LDSH_OFF)};
                pg8::gemm_phase<pg8::EpiRouter, pg8::SchedDense, false>(ring, pg8::Gemm{DM, DM, DM}, S, E, (LAS float*)(Fl.lds + LDSR_OFF));
            }
            PH_END;
            if (PH_ON && EN(14)) { PH_LOCALS route_assign(Fl); }
            PH_END;
            for (int st = 0; st < 3; ++st) {
                if (PH_ON && EN(15)) { PH_LOCALS
                    LAS int* tl = (LAS int*)(Fl.lds + LDSX_OFF); int rot = 0;
                    if (st >= 1) {
                        const int sd = st - 1; const int* tok = (const int*)(ws + RT_TOK) + sd * MOE_ROWS; const int* texp = (const int*)(ws + RT_TEXP) + sd * 272;
                        const int nT = __builtin_amdgcn_readfirstlane(((const int*)(ws + RT_NT))[sd]);
                        if (Fl.tid < 272) tl[Fl.tid] = texp[Fl.tid]; __syncthreads();
                        SchedMoE S{ws, tl, tok, nT, 0, Fl.G, bx, 1, (size_t)sd * MOE_ROWS * D_EXP, 0};
                        pg8::EpiMoeDown E{H, (bf16*)(Fl.ob), ssq_mix, tok, (const float*)(ws + RT_GATE_S) + sd * MOE_ROWS, sd, 1.f / (pg8::F8_W2 * pg8::F8_U)};
                        pg8::gemm_phase<pg8::EpiMoeDown, SchedMoE, false, true>(ring, pg8::Gemm{D_EXP / 2, D_EXP / 2, D_EXP / 2}, S, E, (LAS float*)(Fl.lds + LDSR_OFF));
                        rot = ((nT * 4) % Fl.G + 7) & ~7;
                    }
                    if (st <= 1) {
                        const int* tok = (const int*)(ws + RT_TOK) + st * MOE_ROWS; const int* texp = (const int*)(ws + RT_TEXP) + st * 272;
                        const int nT = __builtin_amdgcn_readfirstlane(((const int*)(ws + RT_NT))[st]);
                        if (Fl.tid < 272) tl[Fl.tid] = texp[Fl.tid]; __syncthreads();
                        SchedMoE S{ws, tl, tok, nT, 1, Fl.G, bx, 1, 0, rot};
                        pg8::EpiSwiglu8<true, D_EXP> E{(unsigned char*)(ws + WS_R) + (size_t)st * MOE_ROWS * D_EXP, ssq_ffn, tok};
                        pg8::gemm_phase<pg8::EpiSwiglu8<true, D_EXP>, SchedMoE, true, true>(ring, pg8::Gemm{DM / 2, DM / 2, DM / 2}, S, E, (LAS float*)(Fl.lds + LDSR_OFF));
                    }
                }
                PH_END;
            }
        }
    }
    if (PH_ON && EN(17)) { PH_LOCALS
        const float* g = INF(25); const int gw = Fl.vcu * NWAVES + Fl.wave, NGW = Fl.G * NWAVES;
        const unsigned tmo = __hip_atomic_load((unsigned*)(ws + WS_CTL) + CW_BAR + XB_TMO, RLX_AGENT);
        f32x4 gg[4];
#pragma unroll
        for (int j = 0; j < 4; ++j) gg[j] = *((const GAS f32x4*)g + Fl.lane + 64 * j);
        for (int m0 = gw * 4; m0 < T; m0 += NGW * 4) {
            unsigned long long w[4][4]; float rs[4];
#pragma unroll
            for (int r = 0; r < 4; ++r) { const int m = m0 + r; rs[r] = pg8::rstd16((const f32x4*)(ssq_mix + (size_t)m * 16));
                const GAS unsigned long long* hr = (const GAS unsigned long long*)(H + (size_t)m * DM) + Fl.lane;
#pragma unroll
                for (int j = 0; j < 4; ++j) w[r][j] = hr[64 * j]; }
#pragma unroll
            for (int r = 0; r < 4; ++r) { GAS f32x4* o = (GAS f32x4*)(args.out + (size_t)(m0 + r) * DM) + Fl.lane;
#pragma unroll
                for (int j = 0; j < 4; ++j) { const unsigned a = (unsigned)w[r][j], b = (unsigned)(w[r][j] >> 32);
                    f32x4 v = {pg8::bf_lo(a) * rs[r] * gg[j].x, pg8::bf_hi(a) * rs[r] * gg[j].y, pg8::bf_lo(b) * rs[r] * gg[j].z, pg8::bf_hi(b) * rs[r] * gg[j].w};
                    if (tmo) v = (f32x4){__builtin_nanf(""), __builtin_nanf(""), __builtin_nanf(""), __builtin_nanf("")};
                    o[64 * j] = v; } } }
    }
    PH_END;
#undef PH_ON
#undef PH_END
#undef PH_LOCALS
}

#ifndef MK_STOP
#define MK_STOP 0
#endif
#ifndef MK_DUMP_OFF
#define MK_DUMP_OFF WS_H
#endif
#ifndef MK_DUMP_INTS
#define MK_DUMP_INTS 0
#endif
__global__ void dump_i32(const int* src, float* out, size_t nint, size_t n) {
    for (size_t i = (size_t)blockIdx.x * blockDim.x + threadIdx.x; i < n; i += (size_t)gridDim.x * blockDim.x) out[i] = i < nint ? (float)src[i] : 0.f;
}
__global__ void dump_bf16(const unsigned short* src, float* out, size_t n) {
    for (size_t i = (size_t)blockIdx.x * blockDim.x + threadIdx.x; i < n; i += (size_t)gridDim.x * blockDim.x) out[i] = __uint_as_float((unsigned)src[i] << 16);
}
extern "C" void kernel_launch(void* const* d_in, const int* in_sizes, int n_in, void* d_out, int out_size, void* d_ws, size_t ws_size, hipStream_t stream) {
    static int grid = 0;
    if (grid == 0) {
        if (n_in != 26 || out_size != T * DM || ws_size < WS_END) { fprintf(stderr, "kernel_launch: unexpected shapes (n_in %d, out %d, ws %zu < %zu)\n", n_in, out_size, ws_size, (size_t)WS_END); grid = -1; return; }
        int dev = 0, cus = 0, per_cu = 0;
        if (hipGetDevice(&dev) != hipSuccess || hipDeviceGetAttribute(&cus, hipDeviceAttributeMultiprocessorCount, dev) != hipSuccess) { grid = -1; return; }
        if (hipFuncSetAttribute((const void*)fwd, hipFuncAttributeMaxDynamicSharedMemorySize, LDS_BYTES) != hipSuccess) { fprintf(stderr, "kernel_launch: hipFuncSetAttribute failed\n"); grid = -1; return; }
        if (hipOccupancyMaxActiveBlocksPerMultiprocessor(&per_cu, (const void*)fwd, NWAVES * 64, LDS_BYTES) != hipSuccess || per_cu < 1) fprintf(stderr, "kernel_launch: occupancy query reports %d\n", per_cu);
        (void)hipGetLastError();
        grid = cus;
    }
    if (grid < 0) return;
    if (hipMemsetAsync((char*)d_ws + WS_CTL, 0, CTL_ZERO_BYTES, stream) != hipSuccess) return;
    Args a{};
    for (int i = 0; i < 26; ++i) a.in[i] = d_in[i];
    a.out = (float*)d_out; a.ws = (unsigned char*)d_ws;
#if MK_MULTI
    const int nph = MK_STOP ? MK_STOP : 2 + 8 + 12 + 8 + 12 + 1;
    for (int p = 0; p < nph; ++p) { a.ph_lo = p; a.ph_hi = p + 1; hipLaunchKernelGGL(fwd, dim3(grid), dim3(NWAVES * 64), LDS_BYTES, stream, a); }
    if (MK_STOP && MK_DUMP_INTS) hipLaunchKernelGGL(dump_i32, dim3(2048), dim3(256), 0, stream, (const int*)((const char*)d_ws + (MK_DUMP_OFF)), (float*)d_out, (size_t)(MK_DUMP_INTS), (size_t)T * DM);
    else if (MK_STOP) hipLaunchKernelGGL(dump_bf16, dim3(2048), dim3(256), 0, stream, (const unsigned short*)((const char*)d_ws + (MK_DUMP_OFF)), (float*)d_out, (size_t)T * DM);
#else
    a.ph_lo = 0; a.ph_hi = 1 << 30;
    hipLaunchKernelGGL(fwd, dim3(grid), dim3(NWAVES * 64), LDS_BYTES, stream, a);
#endif
    const hipError_t le = hipPeekAtLastError();
    if (le != hipSuccess) fprintf(stderr, "kernel_launch: launch failed: %s\n", hipGetErrorName(le));
}
```

```cpp
#include <hip/hip_runtime.h>
#include <hip/hip_bf16.h>
#include <cstdio>
#include <cstdint>
#include <cmath>

constexpr int NB = 8, SEQ = 8192, DM = 1024, T = NB * SEQ, DEPTH = 4;
constexpr int D_IN = 3080, D_INP = 3328, QKVP = 3072;
constexpr int NMEM = 256, D_FF = 2816, NEXP = 8, D_EXP = 3584;
constexpr float EPS = 1e-6f, SUBLN_EPS = 1e-5f;
constexpr float LOG2E = 1.4426950408889634f;
constexpr float C2 = 0.125f * LOG2E;
constexpr float CM = 0.0625f * LOG2E;
constexpr int MOE_ROWS = 67584;
constexpr int MOE_TMAX = 264;

namespace pg8 {
#define PG8_LAS __attribute__((address_space(3)))
typedef unsigned short bf16_t;
typedef short bf16x8 __attribute__((ext_vector_type(8)));
typedef float f32x4 __attribute__((ext_vector_type(4)));
typedef float f32x2 __attribute__((ext_vector_type(2)));
typedef unsigned u32x4 __attribute__((ext_vector_type(4)));
typedef __bf16 bf16x2_t __attribute__((ext_vector_type(2)));
typedef int v4i_t __attribute__((ext_vector_type(4)));
typedef unsigned u32x2 __attribute__((ext_vector_type(2)));
constexpr int BM = 256, BK = 64, HALF = 128, HTB = HALF * BK * 2, STAGE_BYTES = 8 * HTB, NXCD = 8, WGM = 4;

__host__ __device__ __forceinline__ int lds_byte(int r, int c) { const int st = (r >> 4) * 2 + (c >> 5), rr = r & 15, cc = c & 31, ob = rr * 64 + cc * 2; return st * 1024 + (ob ^ (((ob >> 9) & 1) << 5)); }
__host__ __device__ __forceinline__ void stage_rc(int b, int& R, int& C) { const int st = b / 1024, sb = b % 1024, swz = sb ^ (((sb >> 9) & 1) << 5); R = (st >> 1) * 16 + swz / 64; C = (st & 1) * 32 + (swz % 64) / 2; }
__host__ __device__ __forceinline__ int perm32(int rho) { const int n = rho >> 4, i = rho & 15; return 8 * (i >> 2) + 4 * n + (i & 3); }

struct Unit { int pm, pn; const char* a; const char* b; char* o; int aux; const int* ridx; };
struct Gemm { int lda, ldb, K; };

__device__ __forceinline__ bool tile_of(long L, int nM, int nN, int& pm, int& pn);
__device__ __forceinline__ bool tile_order(int i, int G, int c, int nM, int nN, int& pm, int& pn) { return tile_of((long)i * G + c, nM, nN, pm, pn); }
__device__ __forceinline__ bool tile_of(long L, int nM, int nN, int& pm, int& pn) {
    const int nwg = nM * nN; if (L >= nwg) return false;
    int wgid = (int)L; { const int q = nwg / NXCD, r = nwg % NXCD, xcd = wgid % NXCD, off = wgid / NXCD; wgid = (xcd < r ? xcd * (q + 1) : r * (q + 1) + (xcd - r) * q) + off; }
    const int nig = WGM * nN, gid = wgid / nig, fm = gid * WGM, gsz = (nM - fm) < WGM ? (nM - fm) : WGM;
    pm = fm + ((wgid % nig) % gsz); pn = (wgid % nig) / gsz; return true;
}

__device__ __forceinline__ unsigned cvt_pk(float lo, float hi) { f32x2 v = {lo, hi}; bf16x2_t b = __builtin_convertvector(v, bf16x2_t); return __builtin_bit_cast(unsigned, b); }
__device__ __forceinline__ float bf_lo(unsigned u) { return __uint_as_float(u << 16); }
__device__ __forceinline__ float bf_hi(unsigned u) { return __uint_as_float(u & 0xffff0000u); }
__device__ __forceinline__ u32x4 pack8(const f32x4 a, const f32x4 b) { u32x4 w; w.x = cvt_pk(a[0], a[1]); w.y = cvt_pk(a[2], a[3]); w.z = cvt_pk(b[0], b[1]); w.w = cvt_pk(b[2], b[3]); return w; }

__device__ __forceinline__ float rstd_of(float ssq) { return rsqrtf(ssq * (1.0f / 1024.0f) + EPS); }
template <class P> __device__ __forceinline__ float rstd16(P p) { const f32x4 a = p[0], b = p[1], c = p[2], d = p[3]; return rstd_of((((a[0] + a[1]) + (a[2] + a[3])) + ((b[0] + b[1]) + (b[2] + b[3]))) + (((c[0] + c[1]) + (c[2] + c[3])) + ((d[0] + d[1]) + (d[2] + d[3])))); }

typedef f32x4 AccT[2][2][4][2];

#define PG8_GAS __attribute__((address_space(1)))
struct RsPend { f32x4 a, b; };
__device__ __forceinline__ RsPend park_load(const float* ssq, unsigned row, int tid) {
    const PG8_GAS f32x4* p = (const PG8_GAS f32x4*)((const PG8_GAS char*)ssq + (size_t)row * 64u + (tid & 1) * 32u); RsPend r; r.a = p[0]; r.b = p[1]; return r; }
__device__ __forceinline__ void park_store(const RsPend& r, PG8_LAS float* rs, int tid) {
    float v = ((r.a[0] + r.a[1]) + (r.a[2] + r.a[3])) + ((r.b[0] + r.b[1]) + (r.b[2] + r.b[3]));
    v += __int_as_float(__builtin_amdgcn_update_dpp(0, __float_as_int(v), 0xB1, 0xf, 0xf, false));
    if ((tid & 1) == 0) rs[tid >> 1] = rstd_of(v); }
__device__ __forceinline__ RsPend park_none() { RsPend r; r.a = (f32x4){0.f, 0.f, 0.f, 0.f}; r.b = r.a; return r; }
template <class E_, class = void> struct HasLateRs { static constexpr bool value = false; };
template <class E_> struct HasLateRs<E_, decltype((void)E_::LATE_RS)> { static constexpr bool value = true; };
template <class Epi, class Sched, bool GATHER, bool F8 = false>
__device__ __forceinline__ void gemm_phase(PG8_LAS unsigned char* lds, const Gemm g, const Sched& S, const Epi& E, PG8_LAS float* rsbuf) {
    int tid_ = threadIdx.x; asm volatile("" : "+v"(tid_));
    const int tid = tid_, wid = __builtin_amdgcn_readfirstlane(tid >> 6), lane = tid & 63, wr = wid >> 2, wc = wid & 3, fr = lane & 15, fq = lane >> 4;
    const int K = g.K, nt = K / BK;
    int Rs[2], Cs[2];
    unsigned voffB[2], voffC[2][2], voffN[2][2];
#pragma unroll
    for (int i = 0; i < 2; ++i) { stage_rc(tid * 16 + i * 8192, Rs[i], Cs[i]); const int Rb = (Rs[i] & ~31) + perm32(Rs[i] & 31);
        voffB[i] = (unsigned)(Rb * g.ldb + Cs[i]) * 2u; }
    const size_t kstep = (size_t)(BK * 2);
    const size_t hstepB = (size_t)HALF * g.ldb * 2;
    const unsigned ldsw = (unsigned)wid * 1024u;
    const int aoff = lds_byte(wr * 64 + fr, fq * 8), boff = lds_byte(wc * 32 + fr, fq * 8);
#define PG8_SA(b, h) (((b) * 2 + (h)) * HTB)
#define PG8_SB(b, h) ((4 + (b) * 2 + (h)) * HTB)
#define PG8_STAGE(bufoff, gbase, v0, v1) do { \
        __builtin_amdgcn_global_load_lds((const unsigned*)((const char*)(gbase) + (v0)), (PG8_LAS unsigned*)(lds + (bufoff) + ldsw), 16, 0, 0); \
        __builtin_amdgcn_global_load_lds((const unsigned*)((const char*)(gbase) + (v1)), (PG8_LAS unsigned*)(lds + (bufoff) + ldsw + 8192), 16, 0, 0); } while (0)
#define PG8_STAGE_B(bufoff, gbase) PG8_STAGE(bufoff, gbase, voffB[0], voffB[1])
#define PG8_LDA(dst, b, h) do { _Pragma("unroll") for (int m = 0; m < 4; ++m) _Pragma("unroll") for (int k = 0; k < 2; ++k) dst[m][k] = *(const PG8_LAS bf16x8*)(lds + PG8_SA(b, h) + aoff + m * 2048 + k * 1024); } while (0)
#define PG8_LDB(dst, b, h) do { _Pragma("unroll") for (int n = 0; n < 2; ++n) _Pragma("unroll") for (int k = 0; k < 2; ++k) dst[n][k] = *(const PG8_LAS bf16x8*)(lds + PG8_SB(b, h) + boff + n * 2048 + k * 1024); } while (0)
#define PG8_CAT(x0, x1) __builtin_shufflevector(__builtin_bit_cast(v4i_t, x0), __builtin_bit_cast(v4i_t, x1), 0, 1, 2, 3, 4, 5, 6, 7)
#define PG8_MMA(ai, bj, At, Bt, Z) do { __builtin_amdgcn_s_setprio(1); _Pragma("unroll") for (int m = 0; m < 4; ++m) _Pragma("unroll") for (int n = 0; n < 2; ++n) { \
        if constexpr (F8) { if constexpr (Z) asm volatile("v_mfma_f32_16x16x128_f8f6f4 %0, %1, %2, 0" : "=&v"(acc[ai][bj][m][n]) : "v"(PG8_CAT(Bt[n][0], Bt[n][1])), "v"(PG8_CAT(At[m][0], At[m][1]))); \
            else asm volatile("v_mfma_f32_16x16x128_f8f6f4 %0, %1, %2, %0" : "+v"(acc[ai][bj][m][n]) : "v"(PG8_CAT(Bt[n][0], Bt[n][1])), "v"(PG8_CAT(At[m][0], At[m][1]))); }   \
        else { if constexpr (Z) asm volatile("v_mfma_f32_16x16x32_bf16 %0, %1, %2, 0" : "=&v"(acc[ai][bj][m][n]) : "v"(Bt[n][0]), "v"(At[m][0])); \
               else asm volatile("v_mfma_f32_16x16x32_bf16 %0, %1, %2, %0" : "+v"(acc[ai][bj][m][n]) : "v"(Bt[n][0]), "v"(At[m][0])); \
               asm volatile("v_mfma_f32_16x16x32_bf16 %0, %1, %2, %0" : "+v"(acc[ai][bj][m][n]) : "v"(Bt[n][1]), "v"(At[m][1])); } } \
        __builtin_amdgcn_s_setprio(0); } while (0)
#define PG8_WAIT_V(n) asm volatile("s_waitcnt vmcnt(" #n ")" ::: "memory")
#define PG8_WAIT_L(n) asm volatile("s_waitcnt lgkmcnt(" #n ")" ::: "memory")
#define PG8_BAR __builtin_amdgcn_s_barrier()
#define PG8_SCHED __builtin_amdgcn_sched_barrier(0)
#define PG8_VOFF(dst, u) do { _Pragma("unroll") for (int h = 0; h < 2; ++h) _Pragma("unroll") for (int i = 0; i < 2; ++i) { \
        int row_ = h * HALF + Rs[i]; if (GATHER) { row_ = *(const int*)((const char*)(u).ridx + (unsigned)(row_ * 4)); row_ = row_ < 0 ? 0 : row_; } dst[h][i] = (unsigned)(row_ * g.lda + Cs[i]) * 2u; } } while (0)
#define PG8_VRAW(dst, u) do { _Pragma("unroll") for (int h = 0; h < 2; ++h) _Pragma("unroll") for (int i = 0; i < 2; ++i) \
        dst[h][i] = (unsigned)*(const int*)((const char*)(u).ridx + (unsigned)((h * HALF + Rs[i]) * 4)); } while (0)
#define PG8_VCONV(raw, i) ((unsigned)(((int)(raw) < 0 ? 0 : (int)(raw)) * g.lda + Cs[i]) * 2u)
    Unit cur, nxt; int ui = 0;
    if (!S.next(0, cur)) return;
    f32x4 acc[2][2][4][2];
    bf16x8 At[4][2], B0[2][2], B1[2][2];
    PG8_VOFF(voffC, cur);
    const char* cA = cur.a; const char* cB = cur.b;
    PG8_STAGE_B(PG8_SB(0, 0), cB); PG8_STAGE_B(PG8_SB(0, 1), cB + hstepB); PG8_STAGE(PG8_SA(0, 0), cA, voffC[0][0], voffC[0][1]); PG8_STAGE(PG8_SA(0, 1), cA, voffC[1][0], voffC[1][1]);
    if (wr == 1) PG8_BAR;
    PG8_WAIT_V(2); PG8_BAR;
    PG8_STAGE_B(PG8_SB(1, 0), cB + kstep); PG8_STAGE_B(PG8_SB(1, 1), cB + hstepB + kstep);
    PG8_WAIT_V(4); PG8_BAR;
    { const RsPend pv0 = E.pre_load(cur, tid); E.pre_store(pv0, rsbuf, tid); }
    for (;;) {
        const bool has_next = S.next(ui + 1, nxt);
        const char* nA = has_next ? nxt.a : cA; const char* nB = has_next ? nxt.b : cB;
        if constexpr (GATHER) { if (has_next) { PG8_VRAW(voffN, nxt); } else {
#pragma unroll
            for (int h = 0; h < 2; ++h)
#pragma unroll
                for (int i = 0; i < 2; ++i) voffN[h][i] = voffC[h][i]; } }
#define PG8_KBODY(T_, Z_) do { const int t = (T_); \
            const bool last = (t == nt - 2); \
            const char* a1 = cA + (size_t)(t + 1) * kstep; \
            const char* a2 = last ? nA : cA + (size_t)(t + 2) * kstep; const char* b2 = last ? nB : cB + (size_t)(t + 2) * kstep; \
            const char* b3 = b2 + kstep; \
            unsigned v2[2][2]; \
            _Pragma("unroll") for (int h = 0; h < 2; ++h) _Pragma("unroll") for (int i = 0; i < 2; ++i) { v2[h][i] = voffC[h][i]; if (GATHER && last && has_next) { voffN[h][i] = PG8_VCONV(voffN[h][i], i); v2[h][i] = voffN[h][i]; } } \
              \
            PG8_LDB(B0, 0, 0); PG8_LDB(B1, 0, 1); PG8_SCHED; PG8_LDA(At, 0, 0); PG8_STAGE(PG8_SA(1, 0), a1, voffC[0][0], voffC[0][1]); PG8_STAGE(PG8_SA(1, 1), a1, voffC[1][0], voffC[1][1]); \
            PG8_WAIT_V(8); PG8_WAIT_L(0); PG8_BAR; PG8_MMA(0, 0, At, B0, Z_); PG8_MMA(0, 1, At, B1, Z_); PG8_BAR; PG8_SCHED; \
              \
            PG8_LDA(At, 0, 1); PG8_STAGE_B(PG8_SB(0, 0), b2); PG8_STAGE_B(PG8_SB(0, 1), b2 + hstepB); \
            PG8_WAIT_V(6); PG8_WAIT_L(0); PG8_BAR; PG8_MMA(1, 0, At, B0, Z_); PG8_MMA(1, 1, At, B1, Z_); PG8_BAR; PG8_SCHED; \
              \
            PG8_LDB(B0, 1, 0); PG8_LDB(B1, 1, 1); PG8_SCHED; PG8_LDA(At, 1, 0); PG8_STAGE(PG8_SA(0, 0), a2, v2[0][0], v2[0][1]); PG8_STAGE(PG8_SA(0, 1), a2, v2[1][0], v2[1][1]); \
            PG8_WAIT_V(8); PG8_WAIT_L(0); PG8_BAR; PG8_MMA(0, 0, At, B0, false); PG8_MMA(0, 1, At, B1, false); PG8_BAR; PG8_SCHED; \
              \
            PG8_LDA(At, 1, 1); PG8_STAGE_B(PG8_SB(1, 0), b3); PG8_STAGE_B(PG8_SB(1, 1), b3 + hstepB); \
            PG8_WAIT_V(6); PG8_WAIT_L(0); PG8_BAR; PG8_MMA(1, 0, At, B0, false); PG8_MMA(1, 1, At, B1, false); PG8_BAR; PG8_SCHED; } while (0)
        PG8_KBODY(0, true);
#pragma nounroll
        for (int t2 = 2; t2 < nt; t2 += 2) PG8_KBODY(t2, false);
        if (wr == 0) PG8_BAR;
        asm volatile("s_nop 15\n\ts_nop 15" ::: "memory");
        { int tid_e = threadIdx.x; asm volatile("" : "+v"(tid_e)); const int fr_e = tid_e & 15, fq_e = (tid_e >> 4) & 3;
          constexpr bool late_rs = HasLateRs<Epi>::value;
          RsPend pv = park_none(); if (!late_rs && has_next) pv = E.pre_load(nxt, tid_e);
          E(acc, cur, wr, wc, fr_e, fq_e, rsbuf + (ui & 1) * 256);
          if (late_rs && has_next) pv = E.pre_load(nxt, tid_e);
          if (has_next) E.pre_store(pv, rsbuf + ((ui + 1) & 1) * 256, tid_e); }
        if (!has_next) break;
        cur = nxt; cA = nA; cB = nB; ++ui;
        if constexpr (GATHER) {
#pragma unroll
        for (int h = 0; h < 2; ++h)
#pragma unroll
            for (int i = 0; i < 2; ++i) voffC[h][i] = voffN[h][i]; }
        if (wr == 1) PG8_BAR;
    }
    PG8_WAIT_V(0);
    PG8_BAR;
#undef PG8_KBODY
#undef PG8_SA
#undef PG8_SB
#undef PG8_STAGE
#undef PG8_STAGE_B
#undef PG8_LDA
#undef PG8_LDB
#undef PG8_MMA
#undef PG8_CAT
#undef PG8_WAIT_V
#undef PG8_WAIT_L
#undef PG8_BAR
#undef PG8_SCHED
#undef PG8_VOFF
#undef PG8_VRAW
#undef PG8_VCONV
}

template <class V_, class P_> __device__ __forceinline__ void PG8_STORE(const V_& v_, P_ p_) { *p_ = v_; }
#define PG8_AT(T_, base, off) ((PG8_GAS T_*)((PG8_GAS char*)(base) + (unsigned)(off)))
#define PG8_ATC(T_, base, off) ((const PG8_GAS T_*)((const PG8_GAS char*)(base) + (unsigned)(off)))

__device__ __forceinline__ unsigned pk_fp8x4(float a, float b, float c, float d) { int v = 0; v = __builtin_amdgcn_cvt_pk_fp8_f32(a, b, v, false); v = __builtin_amdgcn_cvt_pk_fp8_f32(c, d, v, true); return (unsigned)v; }
constexpr float F8_W1 = 32.f, F8_W2 = 64.f, F8_U = 4.f, F8_P = 256.f, F8_X = 8.f;
struct EpiIn {
    bf16_t* QKV; const float* ssq; const float* cs; const float* sn; float* logf; const float* fbias; unsigned* kmx;
    __device__ __forceinline__ RsPend pre_load(const Unit& u, int tid) const { return park_load(ssq, (unsigned)(u.pm * BM + (tid >> 1)), tid); }
    __device__ __forceinline__ void pre_store(const RsPend& r, PG8_LAS float* rs, int tid) const { park_store(r, rs, tid); }
    __device__ __forceinline__ void operator()(const AccT& acc, const Unit& u, int wr, int wc, int fr, int fq, const PG8_LAS float* rsl) const {
        const unsigned rl = (unsigned)(wr * 64 + fr);
        const bool knorm = (u.pn == 8 || u.pn == 9); float kx[2] = {0.f, 0.f};
        const float* ssqb = ssq + (size_t)u.pm * BM * 16;
        if (u.pn == 12) {
            if (wc == 0 && fq == 0) {
                const f32x4 b0 = *(const f32x4*)(fbias), b1 = *(const f32x4*)(fbias + 4);
                float* lb = logf + (size_t)u.pm * BM * 8;
#pragma unroll
                for (int ai = 0; ai < 2; ++ai)
#pragma unroll
                    for (int m = 0; m < 4; ++m) { const unsigned r = rl + ai * HALF + m * 16; const float rs = rsl[r];
                        f32x4 x0 = acc[ai][0][m][0] * rs + b0, x1 = acc[ai][0][m][1] * rs + b1, y0, y1;
#pragma unroll
                        for (int k = 0; k < 4; ++k) { y0[k] = fminf(x0[k], 0.f) - log1pf(__expf(-fabsf(x0[k]))); y1[k] = fminf(x1[k], 0.f) - log1pf(__expf(-fabsf(x1[k]))); }
                        *PG8_AT(f32x4, lb, r * 32u) = y0; *PG8_AT(f32x4, lb, r * 32u + 16u) = y1; }
            }
            return;
        }
        const float sc = (u.pn < 2 || u.pn == 6 || u.pn == 7) ? C2 : 1.f;
        const bool rope = (u.pn < 4) && ((wc & 1) == 0);
        const float sgn = (fq == 0) ? -1.f : 1.f;
        bf16_t* ob = QKV + (size_t)u.pm * BM * QKVP + u.pn * BM;
        const float* csb = cs + (size_t)u.pm * BM * 8; const float* snb = sn + (size_t)u.pm * BM * 8;
        const unsigned co = (unsigned)(wc * 32 + 8 * fq) * 2u;
#pragma unroll
        for (int ai = 0; ai < 2; ++ai)
#pragma unroll
            for (int m = 0; m < 4; ++m) { const unsigned r = rl + ai * HALF + m * 16; const float rs = rsl[r];
                f32x4 c0 = {1.f, 1.f, 1.f, 1.f}, c1 = c0, s0 = {0.f, 0.f, 0.f, 0.f}, s1 = s0;
                if (rope && fq < 2) { c0 = *PG8_ATC(f32x4, csb, r * 32u); c1 = *PG8_ATC(f32x4, csb, r * 32u + 16u); s0 = *PG8_ATC(f32x4, snb, r * 32u); s1 = *PG8_ATC(f32x4, snb, r * 32u + 16u); }
                const unsigned oo = r * (unsigned)(QKVP * 2) + co;
#pragma unroll
                for (int bj = 0; bj < 2; ++bj) { f32x4 v0 = acc[ai][bj][m][0] * rs, v1 = acc[ai][bj][m][1] * rs;
                    if (rope) { f32x4 p0, p1;
#pragma unroll
                        for (int k = 0; k < 4; ++k) { p0[k] = __shfl_xor(v0[k], 16); p1[k] = __shfl_xor(v1[k], 16); }
                        v0 = v0 * c0 + (p0 * s0) * sgn; v1 = v1 * c1 + (p1 * s1) * sgn; }
                    v0 = v0 * sc; v1 = v1 * sc;
                    if (knorm) { float q_ = (v0[0] * v0[0] + v0[1] * v0[1]) + (v0[2] * v0[2] + v0[3] * v0[3]) + (v1[0] * v1[0] + v1[1] * v1[1]) + (v1[2] * v1[2] + v1[3] * v1[3]);
                        q_ += __shfl_xor(q_, 16); q_ += __shfl_xor(q_, 32); kx[bj] = fmaxf(kx[bj], q_); }
                    PG8_STORE(pack8(v0, v1), PG8_AT(u32x4, ob, oo + bj * 256u)); }
                if (m & 1) asm volatile("" ::: "memory"); }
        if (knorm) {
#pragma unroll
            for (int bj = 0; bj < 2; ++bj) { float q_ = kx[bj];
#pragma unroll
                for (int o_ = 1; o_ < 16; o_ <<= 1) q_ = fmaxf(q_, __shfl_xor(q_, o_));
                if (fr == 0 && fq == 0) __hip_atomic_fetch_max(kmx + (u.pm >> 5) * 16 + ((u.pn - 8) * 4 + bj * 2 + (wc >> 1)) * 2 + (wc & 1), __float_as_uint(q_ * 1.03f), __ATOMIC_RELAXED, __HIP_MEMORY_SCOPE_AGENT); }
        }
    }
};

template <bool SCATTER> struct EpiRes {
    bf16_t* H; float* ssq; const int* tok; const float* gate; unsigned char* h8; float osc;
    __device__ __forceinline__ RsPend pre_load(const Unit&, int) const { return park_none(); }
    __device__ __forceinline__ void pre_store(const RsPend&, PG8_LAS float*, int) const {}
    __device__ __forceinline__ void operator()(const AccT& acc, const Unit& u, int wr, int wc, int fr, int fq, const PG8_LAS float* rsl) const {
        const unsigned rl = (unsigned)(wr * 64 + fr);
        bf16_t* hb = H + u.pn * BM + (SCATTER ? (size_t)0 : (size_t)u.pm * BM * DM); unsigned char* h8b = h8 + (size_t)u.pm * BM * DM + u.pn * BM;
        float* sb = ssq + (SCATTER ? 0 : u.pm * BM * 16) + u.pn * 4 + wc;
        const int* tb = tok + u.aux; const float* gb = gate + u.aux;
        const unsigned co = (unsigned)(wc * 32 + 8 * fq) * 2u;
#pragma unroll
        for (int ai = 0; ai < 2; ++ai)
#pragma unroll
            for (int m = 0; m < 4; ++m) { const unsigned r = rl + ai * HALF + m * 16;
                int row = (int)r; float gs = osc;
                if (SCATTER) { row = *PG8_ATC(int, tb, r * 4u); gs = *PG8_ATC(float, gb, r * 4u); }
                const bool valid = row >= 0; float ss = 0.f;
                if (valid) { const unsigned ho = (unsigned)row * (unsigned)(DM * 2) + co;
#pragma unroll
                    for (int bj = 0; bj < 2; ++bj) { const u32x4 old = *PG8_ATC(u32x4, hb, ho + bj * 256u); const f32x4 a0 = acc[ai][bj][m][0] * gs, a1 = acc[ai][bj][m][1] * gs;
                        u32x4 w; w.x = cvt_pk(bf_lo(old.x) + a0[0], bf_hi(old.x) + a0[1]); w.y = cvt_pk(bf_lo(old.y) + a0[2], bf_hi(old.y) + a0[3]);
                        w.z = cvt_pk(bf_lo(old.z) + a1[0], bf_hi(old.z) + a1[1]); w.w = cvt_pk(bf_lo(old.w) + a1[2], bf_hi(old.w) + a1[3]);
                        *PG8_AT(u32x4, hb, ho + bj * 256u) = w;
                        if (h8) *PG8_AT(u32x2, h8b, (unsigned)row * (unsigned)DM + (co >> 1) + bj * 128u) = (u32x2){pk_fp8x4(bf_lo(w.x), bf_hi(w.x), bf_lo(w.y), bf_hi(w.y)), pk_fp8x4(bf_lo(w.z), bf_hi(w.z), bf_lo(w.w), bf_hi(w.w))};
                        ss += bf_lo(w.x) * bf_lo(w.x) + bf_hi(w.x) * bf_hi(w.x) + bf_lo(w.y) * bf_lo(w.y) + bf_hi(w.y) * bf_hi(w.y) + bf_lo(w.z) * bf_lo(w.z) + bf_hi(w.z) * bf_hi(w.z) + bf_lo(w.w) * bf_lo(w.w) + bf_hi(w.w) * bf_hi(w.w); } }
                if (ssq) { ss += __shfl_xor(ss, 16); ss += __shfl_xor(ss, 32); if (fq == 0 && valid) *PG8_AT(float, sb, (unsigned)row * 64u) = ss; }
                if (m & 1) asm volatile("" ::: "memory"); }
    }
};

struct EpiMoeDown {
    bf16_t* H; bf16_t* Y; float* ssq; const int* tok; const float* gate; int pass; float osc;
    __device__ __forceinline__ RsPend pre_load(const Unit&, int) const { return park_none(); }
    __device__ __forceinline__ void pre_store(const RsPend&, PG8_LAS float*, int) const {}
    __device__ __forceinline__ void operator()(const AccT& acc, const Unit& u, int wr, int wc, int fr, int fq, const PG8_LAS float* rsl) const {
        const unsigned rl = (unsigned)(wr * 64 + fr);
        bf16_t* hb = H + u.pn * BM; bf16_t* yb = Y + u.pn * BM;
        const int* tb = tok + u.aux; const float* gb = gate + u.aux;
        const unsigned co = (unsigned)(wc * 32 + 8 * fq) * 2u;
#pragma unroll
        for (int ai = 0; ai < 2; ++ai)
#pragma unroll
            for (int m = 0; m < 4; ++m) { const unsigned r = rl + ai * HALF + m * 16;
                const int row = *PG8_ATC(int, tb, r * 4u); const float gs = *PG8_ATC(float, gb, r * 4u) * osc;
                const bool valid = row >= 0; float ss = 0.f;
                if (valid) { const unsigned ho = (unsigned)row * (unsigned)(DM * 2) + co;
#pragma unroll
                    for (int bj = 0; bj < 2; ++bj) { const f32x4 a0 = acc[ai][bj][m][0] * gs, a1 = acc[ai][bj][m][1] * gs;
                        if (pass == 0) { *PG8_AT(u32x4, yb, ho + bj * 256u) = pack8(a0, a1); }
                        else { const u32x4 old = *PG8_ATC(u32x4, hb, ho + bj * 256u), y = *PG8_ATC(u32x4, yb, ho + bj * 256u);
                            u32x4 w; w.x = cvt_pk(bf_lo(old.x) + (bf_lo(y.x) + a0[0]), bf_hi(old.x) + (bf_hi(y.x) + a0[1])); w.y = cvt_pk(bf_lo(old.y) + (bf_lo(y.y) + a0[2]), bf_hi(old.y) + (bf_hi(y.y) + a0[3]));
                            w.z = cvt_pk(bf_lo(old.z) + (bf_lo(y.z) + a1[0]), bf_hi(old.z) + (bf_hi(y.z) + a1[1])); w.w = cvt_pk(bf_lo(old.w) + (bf_lo(y.w) + a1[2]), bf_hi(old.w) + (bf_hi(y.w) + a1[3]));
                            *PG8_AT(u32x4, hb, ho + bj * 256u) = w;
                            ss += bf_lo(w.x) * bf_lo(w.x) + bf_hi(w.x) * bf_hi(w.x) + bf_lo(w.y) * bf_lo(w.y) + bf_hi(w.y) * bf_hi(w.y) + bf_lo(w.z) * bf_lo(w.z) + bf_hi(w.z) * bf_hi(w.z) + bf_lo(w.w) * bf_lo(w.w) + bf_hi(w.w) * bf_hi(w.w); } } }
                if (pass != 0) { ss += __shfl_xor(ss, 16); ss += __shfl_xor(ss, 32); if (fq == 0 && valid) *PG8_AT(float, ssq + u.pn * 4 + wc, (unsigned)row * 64u) = ss; }
                if (m & 1) asm volatile("" ::: "memory"); }
    }
};

template <bool RS, int LDO> struct EpiPlain {
    const float* ssq; float sc;
    __device__ __forceinline__ RsPend pre_load(const Unit& u, int tid) const { return RS ? park_load(ssq, (unsigned)(u.pm * BM + (tid >> 1)), tid) : park_none(); }
    __device__ __forceinline__ void pre_store(const RsPend& r, PG8_LAS float* rs, int tid) const { if (RS) park_store(r, rs, tid); }
    __device__ __forceinline__ void operator()(const AccT& acc, const Unit& u, int wr, int wc, int fr, int fq, const PG8_LAS float* rsl) const {
        const unsigned rl = (unsigned)(wr * 64 + fr); const float* ssqb = ssq + (RS ? u.pm * BM * 16 : 0);
        const unsigned co = (unsigned)(wc * 32 + 8 * fq) * 2u;
#pragma unroll
        for (int ai = 0; ai < 2; ++ai)
#pragma unroll
            for (int m = 0; m < 4; ++m) { const unsigned r = rl + ai * HALF + m * 16; float rs = sc; if (RS) rs *= rsl[r];
                const unsigned oo = r * (unsigned)((LDO ? LDO : u.aux) * 2) + co;
#pragma unroll
                for (int bj = 0; bj < 2; ++bj) *PG8_AT(u32x4, u.o, oo + bj * 256u) = pack8(acc[ai][bj][m][0] * rs, acc[ai][bj][m][1] * rs);
                if (m & 1) asm volatile("" ::: "memory"); }
    }
};

template <int LDO> struct EpiPlain8 {
    float sc;
    __device__ __forceinline__ RsPend pre_load(const Unit&, int) const { return park_none(); }
    __device__ __forceinline__ void pre_store(const RsPend&, PG8_LAS float*, int) const {}
    __device__ __forceinline__ void operator()(const AccT& acc, const Unit& u, int wr, int wc, int fr, int fq, const PG8_LAS float* rsl) const {
        const unsigned rl = (unsigned)(wr * 64 + fr);
        const unsigned co = (unsigned)(wc * 32 + 8 * fq);
#pragma unroll
        for (int ai = 0; ai < 2; ++ai)
#pragma unroll
            for (int m = 0; m < 4; ++m) { const unsigned r = rl + ai * HALF + m * 16; const unsigned oo = r * (unsigned)LDO + co;
#pragma unroll
                for (int bj = 0; bj < 2; ++bj) { const f32x4 a0 = acc[ai][bj][m][0] * sc, a1 = acc[ai][bj][m][1] * sc;
                    *PG8_AT(u32x2, u.o, oo + bj * 128u) = (u32x2){pk_fp8x4(a0[0], a0[1], a0[2], a0[3]), pk_fp8x4(a1[0], a1[1], a1[2], a1[3])}; }
                if (m & 1) asm volatile("" ::: "memory"); }
    }
};

template <bool MOE, int LDU> struct EpiSwiglu8 {
    unsigned char* U; const float* ssq; const int* tok;
    __device__ __forceinline__ RsPend pre_load(const Unit& u, int tid) const { int row = u.aux + (tid >> 1); if (MOE) { row = tok[row]; row = row < 0 ? 0 : row; } return park_load(ssq, (unsigned)row, tid); }
    __device__ __forceinline__ void pre_store(const RsPend& r, PG8_LAS float* rs, int tid) const { park_store(r, rs, tid); }
    __device__ __forceinline__ void operator()(const AccT& acc, const Unit& u, int wr, int wc, int fr, int fq, const PG8_LAS float* rsl) const {
        const unsigned rl = (unsigned)(wr * 64 + fr);
        unsigned char* ub = U + (size_t)u.aux * LDU + u.pn * HALF;
        const unsigned co = (unsigned)(wc * 32 + 8 * fq);
#pragma unroll
        for (int ai = 0; ai < 2; ++ai)
#pragma unroll
            for (int m = 0; m < 4; ++m) { const unsigned r = rl + ai * HALF + m * 16;
                const float rs = rsl[r] * (1.f / F8_W1), c2 = -LOG2E * rs, c3 = rs * rs * F8_U;
                f32x4 o[2];
#pragma unroll
                for (int n = 0; n < 2; ++n) { const f32x4 a = acc[ai][0][m][n], b = acc[ai][1][m][n]; const f32x4 t = a * c2; f32x4 e, rr;
#pragma unroll
                    for (int k = 0; k < 4; ++k) e[k] = __builtin_amdgcn_exp2f(t[k]);
                    const f32x4 d = e + 1.f;
#pragma unroll
                    for (int k = 0; k < 4; ++k) rr[k] = __builtin_amdgcn_rcpf(d[k]);
                    o[n] = ((a * b) * c3) * rr; }
                PG8_STORE((u32x2){pk_fp8x4(o[0][0], o[0][1], o[0][2], o[0][3]), pk_fp8x4(o[1][0], o[1][1], o[1][2], o[1][3])}, PG8_AT(u32x2, ub, r * (unsigned)LDU + co));
                if (m & 1) asm volatile("" ::: "memory"); }
    }
};

template <bool MOE, int LDU> struct EpiSwiglu {
    bf16_t* U; const float* ssq; const int* tok;
    __device__ __forceinline__ RsPend pre_load(const Unit& u, int tid) const { int row = u.aux + (tid >> 1); if (MOE) { row = tok[row]; row = row < 0 ? 0 : row; } return park_load(ssq, (unsigned)row, tid); }
    __device__ __forceinline__ void pre_store(const RsPend& r, PG8_LAS float* rs, int tid) const { park_store(r, rs, tid); }
    __device__ __forceinline__ void operator()(const AccT& acc, const Unit& u, int wr, int wc, int fr, int fq, const PG8_LAS float* rsl) const {
        const unsigned rl = (unsigned)(wr * 64 + fr);
        bf16_t* ub = U + (size_t)u.aux * LDU + u.pn * HALF; const int* tb = tok + u.aux; const float* sb = ssq + (MOE ? 0 : u.aux * 16);
        const unsigned co = (unsigned)(wc * 32 + 8 * fq) * 2u;
#pragma unroll
        for (int ai = 0; ai < 2; ++ai)
#pragma unroll
            for (int m = 0; m < 4; ++m) { const unsigned r = rl + ai * HALF + m * 16;
                const float rs = rsl[r], c2 = -LOG2E * rs, c3 = rs * rs;
                f32x4 o[2];
#pragma unroll
                for (int n = 0; n < 2; ++n) { const f32x4 a = acc[ai][0][m][n], b = acc[ai][1][m][n]; const f32x4 t = a * c2; f32x4 e, rr;
#pragma unroll
                    for (int k = 0; k < 4; ++k) e[k] = __builtin_amdgcn_exp2f(t[k]);
                    const f32x4 d = e + 1.f;
#pragma unroll
                    for (int k = 0; k < 4; ++k) rr[k] = __builtin_amdgcn_rcpf(d[k]);
                    o[n] = ((a * b) * c3) * rr; }
                PG8_STORE(pack8(o[0], o[1]), PG8_AT(u32x4, ub, r * (unsigned)(LDU * 2) + co));
                if (m & 1) asm volatile("" ::: "memory"); }
    }
};

__device__ __forceinline__ float quad_max(float v) { auto a = __builtin_amdgcn_permlane16_swap(__float_as_uint(v), __float_as_uint(v), false, false); v = fmaxf(__uint_as_float(a[0]), __uint_as_float(a[1]));
    auto b = __builtin_amdgcn_permlane32_swap(__float_as_uint(v), __float_as_uint(v), false, false); return fmaxf(__uint_as_float(b[0]), __uint_as_float(b[1])); }
__device__ __forceinline__ float quad_sum(float v) { auto a = __builtin_amdgcn_permlane16_swap(__float_as_uint(v), __float_as_uint(v), false, false); v = __uint_as_float(a[0]) + __uint_as_float(a[1]);
    auto b = __builtin_amdgcn_permlane32_swap(__float_as_uint(v), __float_as_uint(v), false, false); return __uint_as_float(b[0]) + __uint_as_float(b[1]); }
template <bool P8> struct EpiSoftmax {
    static constexpr bool LATE_RS = true;
    PG8_LAS float* X; const float* ssq; float sc;
    __device__ __forceinline__ RsPend pre_load(const Unit& u, int tid) const { return park_load(ssq, (unsigned)(u.pm * BM + (tid >> 1)), tid); }
    __device__ __forceinline__ void pre_store(const RsPend& r, PG8_LAS float* rs, int tid) const { park_store(r, rs, tid); }
    __device__ __forceinline__ void operator()(AccT& acc, const Unit& u, int wr, int wc, int fr, int fq, const PG8_LAS float* rsl) const {
        const int rl = wr * 64 + fr;
#pragma unroll
        for (int ai = 0; ai < 2; ++ai)
#pragma unroll
            for (int m = 0; m < 4; ++m) { float v = -INFINITY; const float rs_ = rsl[rl + ai * HALF + m * 16] * sc;
#pragma unroll
                for (int bj = 0; bj < 2; ++bj)
#pragma unroll
                    for (int n = 0; n < 2; ++n) { const f32x4 x = acc[ai][bj][m][n] * rs_; acc[ai][bj][m][n] = x; v = fmaxf(v, fmaxf(fmaxf(x[0], x[1]), fmaxf(x[2], x[3]))); }
                v = quad_max(v);
                if (fq == 0) X[(rl + ai * HALF + m * 16) * 4 + wc] = v; asm volatile("" ::: "memory"); }
        asm volatile("s_waitcnt lgkmcnt(0)" ::: "memory"); __builtin_amdgcn_s_barrier(); asm volatile("" ::: "memory");
        int rl2 = rl; asm volatile("" : "+v"(rl2));
#pragma unroll
        for (int ai = 0; ai < 2; ++ai)
#pragma unroll
            for (int m = 0; m < 4; ++m) { const int r = rl2 + ai * HALF + m * 16; const f32x4 q = *(const PG8_LAS f32x4*)(X + r * 4);
                const float M = fmaxf(fmaxf(q[0], q[1]), fmaxf(q[2], q[3])); float s = 0.f;
#pragma unroll
                for (int bj = 0; bj < 2; ++bj)
#pragma unroll
                    for (int n = 0; n < 2; ++n) { f32x4 e;
#pragma unroll
                        for (int k = 0; k < 4; ++k) { e[k] = __builtin_amdgcn_exp2f(acc[ai][bj][m][n][k] - M); s += e[k]; }
                        acc[ai][bj][m][n] = e; }
                s = quad_sum(s);
                if (fq == 0) X[1024 + r * 4 + wc] = s; asm volatile("" ::: "memory"); }
        asm volatile("s_waitcnt lgkmcnt(0)" ::: "memory"); __builtin_amdgcn_s_barrier(); asm volatile("" ::: "memory");
        const unsigned co = (unsigned)(wc * 32 + 8 * fq) * 2u;
        int rl3 = rl; asm volatile("" : "+v"(rl3));
#pragma unroll
        for (int ai = 0; ai < 2; ++ai)
#pragma unroll
            for (int m = 0; m < 4; ++m) { const int r = rl3 + ai * HALF + m * 16; const f32x4 q = *(const PG8_LAS f32x4*)(X + 1024 + r * 4);
                const float inv = __builtin_amdgcn_rcpf((q[0] + q[1]) + (q[2] + q[3])) * (P8 ? F8_P : 1.f);
                const unsigned oo = P8 ? (unsigned)r * (unsigned)DM + (co >> 1) : (unsigned)r * (unsigned)(DM * 2) + co;
#pragma unroll
                for (int bj = 0; bj < 2; ++bj) { const f32x4 a0 = acc[ai][bj][m][0] * inv, a1 = acc[ai][bj][m][1] * inv;
                    if constexpr (P8) PG8_STORE((u32x2){pk_fp8x4(a0[0], a0[1], a0[2], a0[3]), pk_fp8x4(a1[0], a1[1], a1[2], a1[3])}, PG8_AT(u32x2, u.o, oo + bj * 128u));
                    else PG8_STORE(pack8(a0, a1), PG8_AT(u32x4, u.o, oo + bj * 256u)); }
                if (m & 1) asm volatile("" ::: "memory"); }
    }
};

struct EpiRouter {
    const float* ssq; int* choice; float* gates; int* cnt; PG8_LAS int* hist;
    __device__ __forceinline__ RsPend pre_load(const Unit& u, int tid) const { return park_load(ssq, (unsigned)(u.pm * BM + (tid >> 1)), tid); }
    __device__ __forceinline__ void pre_store(const RsPend& r, PG8_LAS float* rs, int tid) const { park_store(r, rs, tid); }
    __device__ __forceinline__ void operator()(const AccT& acc, const Unit& u, int wr, int wc, int fr, int fq, const PG8_LAS float* rsl) const {
        if (wc == 0 && fq == 0) {
            const float* ssqb = ssq + u.pm * BM * 16; int* chb = choice + u.pm * BM; float* gb = gates + u.pm * BM * 2;
#pragma unroll
            for (int ai = 0; ai < 2; ++ai)
#pragma unroll
                for (int m = 0; m < 4; ++m) { const unsigned r = (unsigned)(ai * HALF + wr * 64 + m * 16 + fr); const float rs = rsl[r];
                    float x[8];
#pragma unroll
                    for (int k = 0; k < 4; ++k) { x[k] = acc[ai][0][m][0][k] * rs; x[4 + k] = acc[ai][0][m][1][k] * rs; }
                    int e0 = 0; float v0 = x[0];
#pragma unroll
                    for (int k = 1; k < 8; ++k) if (x[k] > v0) { v0 = x[k]; e0 = k; }
                    int e1 = 0; float v1 = -INFINITY;
#pragma unroll
                    for (int k = 0; k < 8; ++k) if (k != e0 && x[k] > v1) { v1 = x[k]; e1 = k; }
                    if (!(v1 > -INFINITY)) e1 = (e0 + 1) & 7;
                    const float g1 = 1.f / (1.f + __expf(v0 - v1)), g0 = 1.f - g1;
                    *PG8_AT(int, chb, r * 4u) = e0 | (e1 << 8); *PG8_AT(f32x2, gb, r * 8u) = (f32x2){g0, g1};
                    __hip_atomic_fetch_add(hist + e0, 1, __ATOMIC_RELAXED, __HIP_MEMORY_SCOPE_WORKGROUP); __hip_atomic_fetch_add(hist + 8 + e1, 1, __ATOMIC_RELAXED, __HIP_MEMORY_SCOPE_WORKGROUP); }
        }
        asm volatile("s_waitcnt lgkmcnt(0)" ::: "memory"); __builtin_amdgcn_s_barrier(); asm volatile("" ::: "memory");
        { int t_ = wr * 256 + wc * 64 + fq * 16 + fr; if (t_ < 16) { cnt[u.pm * 16 + t_] = hist[t_]; hist[t_] = 0; } }
        asm volatile("s_waitcnt lgkmcnt(0)" ::: "memory"); __builtin_amdgcn_s_barrier(); asm volatile("" ::: "memory");
    }
};

struct SchedDense {
    const char* A; const char* B; char* O; size_t a_tile, b_tile, o_tile; int nM, nN, G, c;
    __device__ __forceinline__ bool next(int i, Unit& u) const {
        if (!tile_order(i, G, c, nM, nN, u.pm, u.pn)) return false;
        u.a = A + (size_t)u.pm * a_tile; u.b = B + (size_t)u.pn * b_tile; u.o = O ? O + (size_t)u.pm * o_tile + (size_t)u.pn * 512 : nullptr; u.aux = u.pm * BM; u.ridx = nullptr; return true; }
};
}

namespace attn_body {
using bf16 = __hip_bfloat16;
using bf16x8 = __attribute__((ext_vector_type(8))) short;
using s16x4 = __attribute__((ext_vector_type(4))) short;
using f32x16 = __attribute__((ext_vector_type(16))) float;
using f32x4 = __attribute__((ext_vector_type(4))) float;
using u32x4 = __attribute__((ext_vector_type(4))) unsigned;
constexpr int D = 64, PQ = QKVP;
constexpr int NW = 8, QBLK = 32, QB = QBLK * NW, KVBLK = 64, NQB = SEQ / QB;
__device__ __forceinline__ int crow(int r, int hi) { return (r & 3) + 8 * (r >> 2) + 4 * hi; }
#define SBAR() __builtin_amdgcn_sched_barrier(0)
__device__ __forceinline__ void cmask(f32x16& p0, f32x16& p1, int jb, int qrel, int hi) {
  const float NEG = -INFINITY; int kb = 64 * jb + 4 * hi;
  #pragma unroll
  for (int r = 0; r < 16; ++r) { int kv = kb + (r & 3) + 8 * (r >> 2); if (kv > qrel) p0[r] = NEG; if (kv + 32 > qrel) p1[r] = NEG; }
}
constexpr int NSLOT = 3, SLOTB = 8192;
constexpr int LDS_K = 0, LDS_V = NSLOT * SLOTB, LDS_WS = 2 * NSLOT * SLOTB, LDS_OST = LDS_WS + NW * 64 * 4, LDS_TAB = LDS_OST + NW * 4096, LDS_BYTES = LDS_TAB + SEQ * 4;
__device__ __forceinline__ void glds16(const void* gsrc, unsigned lds_dst) { unsigned keep;
  asm volatile("s_mov_b32 %0, m0\n\ts_mov_b32 m0, %2\n\ts_nop 0\n\tglobal_load_lds_dwordx4 %1, off\n\ts_mov_b32 m0, %0" : "=&s"(keep) : "v"(gsrc), "s"(lds_dst) : "memory"); }
__device__ __forceinline__ float max3f(float a, float b, float c) { float r; asm("v_max3_f32 %0, %1, %2, %3" : "=v"(r) : "v"(a), "v"(b), "v"(c)); return r; }
__device__ __forceinline__ float max2f(float a, float b) { float r; asm("v_max_f32_e32 %0, %1, %2" : "=v"(r) : "v"(a), "v"(b)); return r; }
__device__ __forceinline__ float fadd_s(float a, float b) { float r; asm("v_add_f32_e32 %0, %1, %2" : "=v"(r) : "v"(a), "v"(b)); return r; }
__device__ __forceinline__ float fsub_s(float a, float b) { float r; asm("v_sub_f32_e32 %0, %1, %2" : "=v"(r) : "v"(a), "v"(b)); return r; }
typedef float f32x2_t __attribute__((ext_vector_type(2))); typedef __bf16 bf16x2_t __attribute__((ext_vector_type(2)));
__device__ __forceinline__ unsigned cvtpk_s(float lo, float hi) { f32x2_t v = {lo, hi}; bf16x2_t b = __builtin_convertvector(v, bf16x2_t); return __builtin_bit_cast(unsigned, b); }
#define WAIT_BAR(N) asm volatile("s_waitcnt vmcnt(" #N ") lgkmcnt(0)\n\ts_barrier" ::: "memory")

__device__ __forceinline__ void qkt(f32x16& p0, f32x16& p1, const char* Kslot, const bf16x8* qr, const f32x16& c0, const f32x16& c1, int r32, int hi) {
  const char* kb = Kslot + hi * 1024 + r32 * 16;
  #pragma unroll
  for (int d0 = 0; d0 < 4; ++d0) {
    const bf16x8 b0 = *reinterpret_cast<const bf16x8*>(kb + d0 * 2048);
    const bf16x8 b1 = *reinterpret_cast<const bf16x8*>(kb + d0 * 2048 + 512);
    if (d0 == 0) { p0 = __builtin_amdgcn_mfma_f32_32x32x16_bf16(b0, qr[0], c0, 0, 0, 0); p1 = __builtin_amdgcn_mfma_f32_32x32x16_bf16(b1, qr[0], c1, 0, 0, 0); }
    else { p0 = __builtin_amdgcn_mfma_f32_32x32x16_bf16(b0, qr[d0], p0, 0, 0, 0); p1 = __builtin_amdgcn_mfma_f32_32x32x16_bf16(b1, qr[d0], p1, 0, 0, 0); } }
}
typedef __attribute__((address_space(3))) const char* lds_cptr;
typedef short v4i16_t __attribute__((ext_vector_type(4)));
__device__ __forceinline__ void kload8(bf16x8* kf, lds_cptr kp) {
  kf[0] = *(const __attribute__((address_space(3))) bf16x8*)(kp);        kf[1] = *(const __attribute__((address_space(3))) bf16x8*)(kp + 512);
  kf[2] = *(const __attribute__((address_space(3))) bf16x8*)(kp + 2048); kf[3] = *(const __attribute__((address_space(3))) bf16x8*)(kp + 2560);
  kf[4] = *(const __attribute__((address_space(3))) bf16x8*)(kp + 4096); kf[5] = *(const __attribute__((address_space(3))) bf16x8*)(kp + 4608);
  kf[6] = *(const __attribute__((address_space(3))) bf16x8*)(kp + 6144); kf[7] = *(const __attribute__((address_space(3))) bf16x8*)(kp + 6656);
}
__device__ __forceinline__ void kload2(bf16x8* kf, lds_cptr kp, int j) { kf[2 * j] = *(const __attribute__((address_space(3))) bf16x8*)(kp + j * 2048); kf[2 * j + 1] = *(const __attribute__((address_space(3))) bf16x8*)(kp + j * 2048 + 512); }
__device__ __forceinline__ s16x4 vtr(lds_cptr p) { return __builtin_bit_cast(s16x4, __builtin_amdgcn_ds_read_tr16_b64_v4i16((__attribute__((address_space(3))) v4i16_t*)p)); }
__device__ __forceinline__ float rowmax(const f32x16& p0, const f32x16& p1) {
  float a = max3f(p0[0], p0[1], p1[0]), b = max3f(p0[2], p0[3], p1[1]); a = max3f(a, p1[2], p1[3]);
  #pragma unroll
  for (int r = 4; r < 16; r += 4) { a = max3f(a, p0[r], p0[r + 1]); b = max3f(b, p0[r + 2], p0[r + 3]); a = max3f(a, p1[r], p1[r + 1]); b = max3f(b, p1[r + 2], p1[r + 3]); }
  const float m = max2f(a, b);
  auto rr = __builtin_amdgcn_permlane32_swap(__float_as_uint(m), __float_as_uint(m), false, false);
  return max2f(__uint_as_float(rr[0]), __uint_as_float(rr[1]));
}
__device__ __forceinline__ void pv(f32x16* o, int vb, bf16x8 pa0, bf16x8 pa1, bf16x8 pa2, bf16x8 pa3) {
  #pragma unroll
  for (int d0 = 0; d0 < 2; ++d0) { s16x4 lo[4], hi[4];
    #pragma unroll
    for (int ks = 0; ks < 4; ++ks) {
      asm volatile("ds_read_b64_tr_b16 %0,%1 offset:%c2" : "=&v"(lo[ks]) : "v"(vb), "i"(d0 * 4096 + ks * 1024) : "memory");
      asm volatile("ds_read_b64_tr_b16 %0,%1 offset:%c2" : "=&v"(hi[ks]) : "v"(vb), "i"(d0 * 4096 + ks * 1024 + 512) : "memory"); }
    asm volatile("s_waitcnt lgkmcnt(0)" ::: "memory"); SBAR();
    #define PK(k) (bf16x8){lo[k][0], lo[k][1], lo[k][2], lo[k][3], hi[k][0], hi[k][1], hi[k][2], hi[k][3]}
    o[d0] = __builtin_amdgcn_mfma_f32_32x32x16_bf16(pa0, PK(0), o[d0], 0, 0, 0);
    o[d0] = __builtin_amdgcn_mfma_f32_32x32x16_bf16(pa1, PK(1), o[d0], 0, 0, 0);
    o[d0] = __builtin_amdgcn_mfma_f32_32x32x16_bf16(pa2, PK(2), o[d0], 0, 0, 0);
    o[d0] = __builtin_amdgcn_mfma_f32_32x32x16_bf16(pa3, PK(3), o[d0], 0, 0, 0);
    #undef PK
  }
}

template <int THRL> __device__ __forceinline__ void fox_unit(int qb, const bf16* Q, const bf16* __restrict__ K, const bf16* __restrict__ V, bf16* O, int po, const float* biasg, float kmaxn, char* shm) {
  constexpr bool BIAS = true;
  int tid_ = threadIdx.x; asm volatile("" : "+v"(tid_));
  const int tid = tid_, lane = tid & 63, r32 = lane & 31, hi = lane >> 5; const int wid = __builtin_amdgcn_readfirstlane(tid >> 6);
  const int q0 = qb * QB;
  const bf16* Qw = Q + (long)(q0 + wid * QBLK) * PQ;
  const unsigned lds0 = (unsigned)(uintptr_t)shm;
  float* wsf = (float*)(shm + LDS_WS) + wid * 64;
  const int NT = (q0 + QB) / KVBLK;
  #define TILE(u) (NT - 1 - (u))
  const __attribute__((address_space(3))) f32x4* tab4 = (const __attribute__((address_space(3))) f32x4*)((lds_cptr)shm + LDS_TAB);
  const bf16* ksrc = K + (long)lane * PQ + wid * 8;
  const bf16* vsrc = V + (long)(16 * (wid & 3) + (lane >> 2)) * PQ + (wid >> 2) * 32 + (lane & 3) * 8;
  const unsigned kdst = lds0 + LDS_K + wid * 1024, vdst = lds0 + LDS_V + wid * 1024;
  #define DMA_K(t, slot) glds16(ksrc + (long)TILE(t) * KVBLK * PQ, (unsigned)__builtin_amdgcn_readfirstlane(kdst + (slot)))
  #define DMA_V(t, slot) glds16(vsrc + (long)TILE(t) * KVBLK * PQ, (unsigned)__builtin_amdgcn_readfirstlane(vdst + (slot)))
  const int vb0 = (int)(lds0 + LDS_V) + ((lane >> 4) & 1) * 32 + (lane & 3) * 8 + (4 * hi + ((lane & 15) >> 2)) * 64;
  const char* Kbase = shm + LDS_K; bf16x8 kf[8];
  const lds_cptr shm3 = (lds_cptr)shm; const lds_cptr kp0 = shm3 + LDS_K + hi * 1024 + r32 * 16; const lds_cptr vp0 = shm3 + LDS_V + ((lane >> 4) & 1) * 32 + (lane & 3) * 8 + (4 * hi + ((lane & 15) >> 2)) * 64;
  DMA_K(0, 0); DMA_V(0, 0); DMA_K(1, SLOTB);
  {
    __attribute__((address_space(3))) f32x4* tw = (__attribute__((address_space(3))) f32x4*)((__attribute__((address_space(3))) char*)shm + LDS_TAB);
    for (int i = tid; i < NT * 16; i += NW * 64) tw[i] = *(const __attribute__((address_space(1))) f32x4*)(const void*)(biasg + 4 * i);
  }
  bf16x8 qr[4];
  #pragma unroll
  for (int d0 = 0; d0 < 4; ++d0) qr[d0] = *reinterpret_cast<const bf16x8*>(&Qw[(long)r32 * PQ + d0 * 16 + hi * 8]);
  float mhat = 0.f, l_reg = 0.f; f32x16 o[2]; o[0] = f32x16{}; o[1] = f32x16{}; f32x16 negm = f32x16{}; asm volatile("" : "+v"(negm));
  const int qrel = wid * QBLK + r32;
  #define CMASK(P0, P1, t) do { int jb_ = 3 - (t); if (jb_ >= 0) cmask(P0, P1, jb_, qrel, hi); } while (0)
  #define BIASFILL(C0, C1, t) do { const __attribute__((address_space(3))) f32x4* tp_ = tab4 + TILE(t) * 16 + hi; \
      _Pragma("unroll") for (int j_ = 0; j_ < 4; ++j_) { const f32x4 a_ = tp_[2 * j_], b_ = tp_[8 + 2 * j_]; \
        C0[4 * j_] = a_[0] - mhat; C0[4 * j_ + 1] = a_[1] - mhat; C0[4 * j_ + 2] = a_[2] - mhat; C0[4 * j_ + 3] = a_[3] - mhat; \
        C1[4 * j_] = b_[0] - mhat; C1[4 * j_ + 1] = b_[1] - mhat; C1[4 * j_ + 2] = b_[2] - mhat; C1[4 * j_ + 3] = b_[3] - mhat; } } while (0)
  bool resc = false;
  #define START(P0, P1) do { const float rm = rowmax(P0, P1); resc = false; \
    { const float dl = max2f(rm, -1.0e4f); mhat = fadd_s(mhat, dl);     \
      _Pragma("unroll") for (int r = 0; r < 16; ++r) { P0[r] = fsub_s(P0[r], dl); P1[r] = fsub_s(P1[r], dl); } \
      if (!BIAS) { _Pragma("unroll") for (int r = 0; r < 16; ++r) negm[r] = -mhat; asm volatile("" : "+v"(negm)); } } \
    _Pragma("unroll") for (int r = 0; r < 16; ++r) P0[r] = __builtin_amdgcn_exp2f(P0[r]); } while (0)
  #define RESC() do { if (resc) { asm volatile("s_waitcnt lgkmcnt(0)" ::: "memory"); \
      _Pragma("unroll") for (int d_ = 0; d_ < 2; ++d_) _Pragma("unroll") for (int r = 0; r < 16; ++r) o[d_][r] *= wsf[crow(r, hi)]; } } while (0)
  f32x16 pA0, pA1, pB0, pB1;
  int sl_prev = 0, sl_cur = 0, sl_next = SLOTB;
  #define ROT() do { sl_prev = sl_cur; sl_cur = sl_next; sl_next = (sl_next == (NSLOT - 1) * SLOTB) ? 0 : sl_next + SLOTB; } while (0)
  DMA_K(2, 2 * SLOTB);
  WAIT_BAR(3);
  if (BIAS) { f32x16 c0, c1; BIASFILL(c0, c1, 0); qkt(pA0, pA1, Kbase, qr, c0, c1, r32, hi); }
  else qkt(pA0, pA1, Kbase, qr, negm, negm, r32, hi);
  asm volatile("s_nop 15\n\ts_nop 7" : "+v"(pA0), "+v"(pA1)); CMASK(pA0, pA1, 0);
  START(pA0, pA1);
  _Pragma("unroll") for (int r = 0; r < 16; ++r) pA1[r] = __builtin_amdgcn_exp2f(pA1[r]);
  WAIT_BAR(0);
  DMA_K(3, 0); DMA_V(1, SLOTB);
  ROT();
  kload8(kf, kp0 + sl_cur);
  WAIT_BAR(2);
  s16x4 vlo[8], vhi[8]; u32x4 pw0, pw1, pw2, pw3;
  #define PKW(P, B) cvtpk_s(P[B], P[B + 1])
  #define PAF(k) __builtin_bit_cast(bf16x8, pw##k)
  #define VFR(i) (bf16x8){vlo[i][0], vlo[i][1], vlo[i][2], vlo[i][3], vhi[i][0], vhi[i][1], vhi[i][2], vhi[i][3]}
  #define PIN(x) asm volatile("" : "+v"(x))
  #define MX3(a, b, c) __builtin_fmaxf(__builtin_fmaxf((a), (b)), (c))
  #define GAPA(MF, A0, A1, A2, A3, W0, W1, PW) do { MF; sacc += A0; sacc += A1; sacc += A2; sacc += A3; PIN(sacc); W0; W1; PIN(PW); SBAR(); } while (0)
  #define EX(v) __builtin_amdgcn_exp2f(v)
  #define GAPB(MF, X, B) do { MF; X[B] = EX(X[B]); X[B + 1] = EX(X[B + 1]); X[B + 2] = EX(X[B + 2]); X[B + 3] = EX(X[B + 3]); PIN(X); SBAR(); } while (0)
  #define VRD(i) do { vlo[i] = vtr(vp_ + (((i) >> 2) * 4096 + ((i) & 3) * 1024)); vhi[i] = vtr(vp_ + (((i) >> 2) * 4096 + ((i) & 3) * 1024 + 512)); } while (0)
  #define KRD(G, j) do { if (G) { kload2(kf, kp0 + sl_next, j); SBAR(); } } while (0)
  #define CI0(C0) (BIAS ? C0 : negm)
  #define STEP(C0, C1, P0, P1, t, GK, GV, GL) do { SBAR(); \
    if (BIAS) { BIASFILL(C0, C1, t); SBAR(); } \
    const lds_cptr vp_ = vp0 + sl_prev; \
    VRD(0); SBAR(); float sacc = (P0[0] + P0[1]); \
    GAPA(C0 = __builtin_amdgcn_mfma_f32_32x32x16_bf16(kf[0], qr[0], CI0(C0), 0, 0, 0), P0[2], P0[3], P0[4], P0[5],     pw0[0] = PKW(P0, 0), pw0[1] = PKW(P0, 2), pw0); \
    VRD(4); SBAR(); GAPA(C1 = __builtin_amdgcn_mfma_f32_32x32x16_bf16(kf[1], qr[0], CI0(C1), 0, 0, 0), P0[6], P0[7], P0[8], P0[9],     pw0[2] = PKW(P0, 4), pw0[3] = PKW(P0, 6), pw0); \
    VRD(1); SBAR(); GAPA(C0 = __builtin_amdgcn_mfma_f32_32x32x16_bf16(kf[2], qr[1], C0, 0, 0, 0),   P0[10], P0[11], P0[12], P0[13], pw1[0] = PKW(P0, 8), pw1[1] = PKW(P0, 10), pw1); \
    VRD(5); SBAR(); GAPA(C1 = __builtin_amdgcn_mfma_f32_32x32x16_bf16(kf[3], qr[1], C1, 0, 0, 0),   P0[14], P0[15], P1[0], P1[1],   pw1[2] = PKW(P0, 12), pw1[3] = PKW(P0, 14), pw1); \
    VRD(2); SBAR(); GAPA(C0 = __builtin_amdgcn_mfma_f32_32x32x16_bf16(kf[4], qr[2], C0, 0, 0, 0),   P1[2], P1[3], P1[4], P1[5],     pw2[0] = PKW(P1, 0), pw2[1] = PKW(P1, 2), pw2); \
    VRD(6); SBAR(); GAPA(C1 = __builtin_amdgcn_mfma_f32_32x32x16_bf16(kf[5], qr[2], C1, 0, 0, 0),   P1[6], P1[7], P1[8], P1[9],     pw2[2] = PKW(P1, 4), pw2[3] = PKW(P1, 6), pw2); \
    VRD(3); SBAR(); GAPA(C0 = __builtin_amdgcn_mfma_f32_32x32x16_bf16(kf[6], qr[3], C0, 0, 0, 0),   P1[10], P1[11], P1[12], P1[13], pw3[0] = PKW(P1, 8), pw3[1] = PKW(P1, 10), pw3); \
    VRD(7); SBAR(); GAPA(C1 = __builtin_amdgcn_mfma_f32_32x32x16_bf16(kf[7], qr[3], C1, 0, 0, 0),   P1[14], P1[15], 0.f, 0.f,       pw3[2] = PKW(P1, 12), pw3[3] = PKW(P1, 14), pw3); \
    l_reg += sacc; \
    if (GK) { DMA_K((t) + 3, sl_cur); } if (GV) { DMA_V((t) + 1, sl_next); } \
    CMASK(C0, C1, t); \
    { float a = MX3(C0[0], C0[1], C1[0]), b = MX3(C0[2], C0[3], C1[1]); a = MX3(a, C1[2], C1[3]); \
      _Pragma("unroll") for (int r = 4; r < 16; r += 4) { a = MX3(a, C0[r], C0[r + 1]); b = MX3(b, C0[r + 2], C0[r + 3]); a = MX3(a, C1[r], C1[r + 1]); b = MX3(b, C1[r + 2], C1[r + 3]); } \
      float rm = __builtin_fmaxf(a, b); { auto rr = __builtin_amdgcn_permlane32_swap(__float_as_uint(rm), __float_as_uint(rm), false, false); rm = __builtin_fmaxf(__uint_as_float(rr[0]), __uint_as_float(rr[1])); } \
      resc = false; \
      if (__builtin_expect(__any(rm > (float)THRL), 0)) { const float dl = __builtin_fmaxf(rm, 0.f); mhat += dl; \
        _Pragma("unroll") for (int r = 0; r < 16; ++r) { C0[r] -= dl; C1[r] -= dl; } \
        if (!BIAS) { _Pragma("unroll") for (int r = 0; r < 16; ++r) negm[r] = -mhat; asm volatile("" : "+v"(negm)); } \
        const float f = __builtin_amdgcn_exp2f(-dl); l_reg *= f; if (hi == 0) wsf[r32] = f; resc = true; } } \
    SBAR(); \
    GAPB(o[0] = __builtin_amdgcn_mfma_f32_32x32x16_bf16(PAF(0), VFR(0), o[0], 0, 0, 0), C0, 0); \
    GAPB(o[1] = __builtin_amdgcn_mfma_f32_32x32x16_bf16(PAF(0), VFR(4), o[1], 0, 0, 0), C0, 4); \
    KRD(GL, 0); GAPB(o[0] = __builtin_amdgcn_mfma_f32_32x32x16_bf16(PAF(1), VFR(1), o[0], 0, 0, 0), C0, 8); \
    KRD(GL, 1); GAPB(o[1] = __builtin_amdgcn_mfma_f32_32x32x16_bf16(PAF(1), VFR(5), o[1], 0, 0, 0), C0, 12); \
    KRD(GL, 2); GAPB(o[0] = __builtin_amdgcn_mfma_f32_32x32x16_bf16(PAF(2), VFR(2), o[0], 0, 0, 0), C1, 0); \
    KRD(GL, 3); GAPB(o[1] = __builtin_amdgcn_mfma_f32_32x32x16_bf16(PAF(2), VFR(6), o[1], 0, 0, 0), C1, 4); \
    GAPB(o[0] = __builtin_amdgcn_mfma_f32_32x32x16_bf16(PAF(3), VFR(3), o[0], 0, 0, 0), C1, 8); \
    GAPB(o[1] = __builtin_amdgcn_mfma_f32_32x32x16_bf16(PAF(3), VFR(7), o[1], 0, 0, 0), C1, 12); \
    } while (0)
  int NE = NT;
  #define ENDW(tt) do { if ((tt) + 3 < NE) { WAIT_BAR(2); } else if ((tt) + 2 < NE) { WAIT_BAR(1); } else { WAIT_BAR(0); } } while (0)
  int t = 1;
  for (; t + 1 < NE; t += 2) {
    if (t == 5 && NT > 8) {
      float qn2 = 0.f;
      #pragma unroll
      for (int d0 = 0; d0 < 4; ++d0)
        #pragma unroll
        for (int k = 0; k < 8; ++k) { const float v = __uint_as_float((unsigned)(unsigned short)qr[d0][k] << 16); qn2 += v * v; }
      { auto rr = __builtin_amdgcn_permlane32_swap(__float_as_uint(qn2), __float_as_uint(qn2), false, false); qn2 = __uint_as_float(rr[0]) + __uint_as_float(rr[1]); }
      float g = __builtin_sqrtf(qn2) * kmaxn - mhat;
      #pragma unroll
      for (int o_ = 1; o_ < 32; o_ <<= 1) g = fmaxf(g, __shfl_xor(g, o_));
      float* gx = (float*)(shm + LDS_OST);
      if (lane == 0) gx[wid] = g;
      asm volatile("s_waitcnt lgkmcnt(0)\n\ts_barrier" ::: "memory");
      float gw = gx[0];
      #pragma unroll
      for (int w_ = 1; w_ < NW; ++w_) gw = fmaxf(gw, gx[w_]);
      const float* tabf = (const float*)(shm + LDS_TAB);
      const bool c0 = lane < NT && (gw + tabf[64 * lane + 63] < -40.f), c1 = lane + 64 < NT && (gw + tabf[64 * (lane + 64) + 63] < -40.f);
      const unsigned long long b0 = __ballot(c0), b1 = __ballot(c1);
      int nskip = (b0 == ~0ull) ? 64 + (int)__builtin_ctzll(~b1 | (1ull << 63)) : (int)__builtin_ctzll(~b0);
      int ne = NT - nskip; ne = ne < 8 ? 8 : ne; ne += ne & 1;
      NE = __builtin_amdgcn_readfirstlane(ne);
    }
    STEP(pB0, pB1, pA0, pA1, t, (t + 3 < NE), (t + 1 < NE), (t + 1 < NE));         ENDW(t);     RESC(); ROT();
    STEP(pA0, pA1, pB0, pB1, t + 1, (t + 4 < NE), (t + 2 < NE), (t + 2 < NE));     ENDW(t + 1); RESC(); ROT();
  }
  STEP(pB0, pB1, pA0, pA1, NE - 1, false, false, false); RESC();
  { float sacc = pB0[0] + pB0[1]; _Pragma("unroll") for (int r = 2; r < 16; ++r) sacc += pB0[r]; _Pragma("unroll") for (int r = 0; r < 16; ++r) sacc += pB1[r]; l_reg += sacc;
    pw0 = (u32x4){PKW(pB0, 0), PKW(pB0, 2), PKW(pB0, 4), PKW(pB0, 6)}; pw1 = (u32x4){PKW(pB0, 8), PKW(pB0, 10), PKW(pB0, 12), PKW(pB0, 14)}; pw2 = (u32x4){PKW(pB1, 0), PKW(pB1, 2), PKW(pB1, 4), PKW(pB1, 6)}; pw3 = (u32x4){PKW(pB1, 8), PKW(pB1, 10), PKW(pB1, 12), PKW(pB1, 14)};
    SBAR(); pv(o, vb0 + sl_cur, PAF(0), PAF(1), PAF(2), PAF(3)); }
  #undef PKW
  #undef PAF
  #undef VFR
  #undef PIN
  #undef MX3
  #undef GAPA
  #undef GAPB
  #undef EX
  #undef VRD
  #undef KRD
  #undef STEP
  #undef ENDW
  #undef CI0
  { auto rr = __builtin_amdgcn_permlane32_swap(__float_as_uint(l_reg), __float_as_uint(l_reg), false, false); l_reg = __uint_as_float(rr[0]) + __uint_as_float(rr[1]); }
  if (hi == 0) wsf[32 + r32] = l_reg; asm volatile("s_waitcnt lgkmcnt(0)" ::: "memory");
  float rli[16];
  #pragma unroll
  for (int r = 0; r < 16; ++r) rli[r] = __builtin_amdgcn_rcpf(wsf[32 + crow(r, hi)]);
  bf16* Ow = O + (long)(q0 + wid * QBLK) * po;
  { bf16* stg = (bf16*)(shm + LDS_OST) + wid * 2048;
    #pragma unroll
    for (int r = 0; r < 16; ++r) { const int orow = crow(r, hi);
      #pragma unroll
      for (int d0 = 0; d0 < 2; ++d0) stg[orow * 64 + d0 * 32 + r32] = __float2bfloat16(o[d0][r] * rli[r]); }
    asm volatile("s_waitcnt lgkmcnt(0)" ::: "memory");
    #pragma unroll
    for (int i = 0; i < 4; ++i) { const int row = i * 8 + (lane >> 3), ch = lane & 7; const u32x4 v = *(const u32x4*)(stg + row * 64 + ch * 8); *(u32x4*)(Ow + (long)row * po + ch * 8) = v; } }
  asm volatile("s_waitcnt lgkmcnt(0)\n\ts_barrier" ::: "memory");
  #undef DMA_K
  #undef DMA_V
  #undef CMASK
  #undef BIASFILL
  #undef START
  #undef RESC
  #undef ROT
  #undef TILE
}

constexpr int DQB = 128, D_NSLOT = 4, D_VSLOT = 16384, D_LDS_K = 0, D_LDS_V = D_NSLOT * SLOTB, D_LDS_X = 0, D_LDS_STG = 65536, D_LDS_WS = D_LDS_V + D_NSLOT * D_VSLOT, D_LDS_ML = D_LDS_WS + NW * 256, D_LDS_BYTES = D_LDS_ML + NW * 256;
static_assert(D_LDS_STG + NW * 4096 <= D_LDS_WS, "O staging overlays the rings only");
template <int THRL> __device__ __forceinline__ void diff_unit(int qb, const bf16* Q, const bf16* __restrict__ K, const bf16* __restrict__ V, bf16* O, int po, char* shm) {
  int tid_ = threadIdx.x; asm volatile("" : "+v"(tid_));
  const int tid = tid_, lane = tid & 63, r32 = lane & 31, hi = lane >> 5; const int wid = __builtin_amdgcn_readfirstlane(tid >> 6);
  const int pr = wid & 3, kh = wid >> 2;
  const int q0 = qb * DQB;
  const bf16* Qw = Q + (long)(q0 + pr * QBLK) * PQ;
  const unsigned lds0 = (unsigned)(uintptr_t)shm;
  float* wsf = (float*)(shm + D_LDS_WS) + wid * 64;
  const int NT = (q0 + DQB) / KVBLK;
  const bf16* ksrc = K + (long)lane * PQ + wid * 8;
  const bf16* vsrc = V + (long)(16 * (wid & 3) + (lane >> 2)) * PQ + (wid >> 2) * 32 + (lane & 3) * 8;
  const unsigned kdst = lds0 + D_LDS_K + wid * 1024, vdst = lds0 + D_LDS_V + wid * 1024;
  #define KSL(x) (((x) & 3) * SLOTB)
  #define VSL(x) (((x) & 3) * D_VSLOT)
  #define DMA_K(t) glds16(ksrc + (long)(t) * KVBLK * PQ, (unsigned)__builtin_amdgcn_readfirstlane(kdst + KSL(t)))
  #define DMA_V(t) do { glds16(vsrc + (long)(t) * KVBLK * PQ, (unsigned)__builtin_amdgcn_readfirstlane(vdst + VSL(t))); \
                        glds16(vsrc + (long)(t) * KVBLK * PQ + 64, (unsigned)__builtin_amdgcn_readfirstlane(vdst + VSL(t) + 8192)); } while (0)
  bf16x8 kf[4];
  const lds_cptr shm3 = (lds_cptr)shm;
  const lds_cptr kp0 = shm3 + D_LDS_K + hi * 1024 + r32 * 16 + kh * 512;
  const lds_cptr vp0 = shm3 + D_LDS_V + ((lane >> 4) & 1) * 32 + (lane & 3) * 8 + (4 * hi + ((lane & 15) >> 2)) * 64 + kh * 2048;
  DMA_K(0); DMA_V(0); DMA_K(1); DMA_V(1);
  bf16x8 qr[4];
  #pragma unroll
  for (int d0 = 0; d0 < 4; ++d0) qr[d0] = *reinterpret_cast<const __attribute__((address_space(1))) bf16x8*>((const __attribute__((address_space(1))) char*)(const void*)&Qw[(long)r32 * PQ + d0 * 16 + hi * 8]);
  float mhat = 0.f, l_reg = 0.f; f32x16 o[4]; o[0] = f32x16{}; o[1] = f32x16{}; o[2] = f32x16{}; o[3] = f32x16{}; f32x16 negm = f32x16{}; asm volatile("" : "+v"(negm));
  const int qrel = pr * QBLK + r32;
  #define CMASK(P, t) do { const int jb_ = (t) - (NT - 2); if (jb_ >= 0) { const int kb_ = 64 * jb_ + 32 * kh + 4 * hi; \
      _Pragma("unroll") for (int r = 0; r < 16; ++r) { if (kb_ + (r & 3) + 8 * (r >> 2) > qrel) P[r] = -INFINITY; } } } while (0)
  bool resc = false;
  #define RESC() do { if (resc) { asm volatile("s_waitcnt lgkmcnt(0)" ::: "memory"); \
      _Pragma("unroll") for (int d_ = 0; d_ < 4; ++d_) _Pragma("unroll") for (int r = 0; r < 16; ++r) o[d_][r] *= wsf[crow(r, hi)]; } } while (0)
  f32x16 pA, pB;
  #define KLD(j, base) kf[j] = *(const __attribute__((address_space(3))) bf16x8*)((base) + (j) * 2048)
  DMA_K(2); DMA_K(3);
  WAIT_BAR(7);
  { KLD(0, kp0); KLD(1, kp0); KLD(2, kp0); KLD(3, kp0);
    pA = __builtin_amdgcn_mfma_f32_32x32x16_bf16(kf[0], qr[0], negm, 0, 0, 0); pA = __builtin_amdgcn_mfma_f32_32x32x16_bf16(kf[1], qr[1], pA, 0, 0, 0);
    pA = __builtin_amdgcn_mfma_f32_32x32x16_bf16(kf[2], qr[2], pA, 0, 0, 0); pA = __builtin_amdgcn_mfma_f32_32x32x16_bf16(kf[3], qr[3], pA, 0, 0, 0); }
  CMASK(pA, 0);
  { float a = fmaxf(fmaxf(pA[0], pA[1]), pA[2]);
    #pragma unroll
    for (int r = 3; r < 15; r += 2) a = fmaxf(fmaxf(a, pA[r]), pA[r + 1]);
    float rm = fmaxf(a, pA[15]); { auto rr = __builtin_amdgcn_permlane32_swap(__float_as_uint(rm), __float_as_uint(rm), false, false); rm = fmaxf(__uint_as_float(rr[0]), __uint_as_float(rr[1])); }
    const float dl = fmaxf(rm, -1.0e4f);
    mhat += dl;
    #pragma unroll
    for (int r = 0; r < 16; ++r) pA[r] = __builtin_amdgcn_exp2f(pA[r] - dl);
    #pragma unroll
    for (int r = 0; r < 16; ++r) negm[r] = -mhat;
    asm volatile("" : "+v"(negm)); }
  WAIT_BAR(4);
  if (4 < NT) DMA_K(4); if (2 < NT) DMA_V(2);
  { const lds_cptr kb_ = kp0 + KSL(1); KLD(0, kb_); KLD(1, kb_); KLD(2, kb_); KLD(3, kb_); }
  if (NT > 4) { WAIT_BAR(4); } else if (NT == 4) { WAIT_BAR(3); } else { WAIT_BAR(1); }
  s16x4 vlo[8], vhi[8]; u32x4 pw0, pw1;
  #define PKW(P, B) cvtpk_s(P[B], P[B + 1])
  #define PAF(k) __builtin_bit_cast(bf16x8, pw##k)
  #define VFR(i) (bf16x8){vlo[i][0], vlo[i][1], vlo[i][2], vlo[i][3], vhi[i][0], vhi[i][1], vhi[i][2], vhi[i][3]}
  #define PIN(x) asm volatile("" : "+v"(x))
  #define MX3(a, b, c) __builtin_fmaxf(__builtin_fmaxf((a), (b)), (c))
  #define EX(v) __builtin_amdgcn_exp2f(v)
  #define VRD(i) do { vlo[i] = vtr(vp_ + (((i) & 3) * 4096 + ((i) >> 2) * 1024)); vhi[i] = vtr(vp_ + (((i) & 3) * 4096 + ((i) >> 2) * 1024 + 512)); } while (0)
  #define GAPA(MF, A0, A1, A2, A3, W0, W1, PW) do { MF; sacc += A0; sacc += A1; sacc += A2; sacc += A3; PIN(sacc); W0; W1; PIN(PW); SBAR(); } while (0)
  #define GAPB(MF, X, B) do { MF; X[B] = EX(X[B]); X[B + 1] = EX(X[B + 1]); PIN(X); SBAR(); } while (0)
  #define STEP(C, P, t) do { SBAR(); \
    if ((t) + 4 < NT) { DMA_K((t) + 4); } if ((t) + 2 < NT) { DMA_V((t) + 2); } SBAR(); \
    const lds_cptr vp_ = vp0 + VSL((t) - 1); \
    VRD(0); VRD(1); SBAR(); float sacc = (P[0] + P[1]); \
    GAPA(C = __builtin_amdgcn_mfma_f32_32x32x16_bf16(kf[0], qr[0], negm, 0, 0, 0), P[2], P[3], P[4], P[5],     pw0[0] = PKW(P, 0), pw0[1] = PKW(P, 2), pw0); \
    VRD(2); VRD(3); SBAR(); \
    GAPA(C = __builtin_amdgcn_mfma_f32_32x32x16_bf16(kf[1], qr[1], C, 0, 0, 0),    P[6], P[7], P[8], P[9],     pw0[2] = PKW(P, 4), pw0[3] = PKW(P, 6), pw0); \
    VRD(4); VRD(5); SBAR(); \
    GAPA(C = __builtin_amdgcn_mfma_f32_32x32x16_bf16(kf[2], qr[2], C, 0, 0, 0),    P[10], P[11], P[12], P[13], pw1[0] = PKW(P, 8), pw1[1] = PKW(P, 10), pw1); \
    VRD(6); VRD(7); SBAR(); \
    GAPA(C = __builtin_amdgcn_mfma_f32_32x32x16_bf16(kf[3], qr[3], C, 0, 0, 0),    P[14], P[15], 0.f, 0.f,     pw1[2] = PKW(P, 12), pw1[3] = PKW(P, 14), pw1); \
    l_reg += sacc; \
    CMASK(C, t); \
    { float a = MX3(C[0], C[1], C[2]); \
      _Pragma("unroll") for (int r = 3; r < 15; r += 2) a = MX3(a, C[r], C[r + 1]); \
      float rm = __builtin_fmaxf(a, C[15]); { auto rr = __builtin_amdgcn_permlane32_swap(__float_as_uint(rm), __float_as_uint(rm), false, false); rm = __builtin_fmaxf(__uint_as_float(rr[0]), __uint_as_float(rr[1])); } \
      resc = false; \
      if (__builtin_expect(__any(rm > (float)THRL), 0)) { const float dl = __builtin_fmaxf(rm, 0.f); mhat += dl; \
        _Pragma("unroll") for (int r = 0; r < 16; ++r) C[r] -= dl; \
        _Pragma("unroll") for (int r = 0; r < 16; ++r) negm[r] = -mhat; asm volatile("" : "+v"(negm)); \
        const float f = __builtin_amdgcn_exp2f(-dl); l_reg *= f; if (hi == 0) wsf[r32] = f; resc = true; } } \
    SBAR(); \
    const bool gl_ = (t) + 1 < NT; const lds_cptr kn_ = kp0 + KSL((t) + 1); \
    GAPB(o[0] = __builtin_amdgcn_mfma_f32_32x32x16_bf16(PAF(0), VFR(0), o[0], 0, 0, 0), C, 0); \
    GAPB(o[1] = __builtin_amdgcn_mfma_f32_32x32x16_bf16(PAF(0), VFR(1), o[1], 0, 0, 0), C, 2); \
    GAPB(o[2] = __builtin_amdgcn_mfma_f32_32x32x16_bf16(PAF(0), VFR(2), o[2], 0, 0, 0), C, 4); \
    GAPB(o[3] = __builtin_amdgcn_mfma_f32_32x32x16_bf16(PAF(0), VFR(3), o[3], 0, 0, 0), C, 6); \
    if (gl_) { KLD(0, kn_); KLD(1, kn_); SBAR(); } \
    GAPB(o[0] = __builtin_amdgcn_mfma_f32_32x32x16_bf16(PAF(1), VFR(4), o[0], 0, 0, 0), C, 8); \
    GAPB(o[1] = __builtin_amdgcn_mfma_f32_32x32x16_bf16(PAF(1), VFR(5), o[1], 0, 0, 0), C, 10); \
    if (gl_) { KLD(2, kn_); KLD(3, kn_); SBAR(); } \
    GAPB(o[2] = __builtin_amdgcn_mfma_f32_32x32x16_bf16(PAF(1), VFR(6), o[2], 0, 0, 0), C, 12); \
    GAPB(o[3] = __builtin_amdgcn_mfma_f32_32x32x16_bf16(PAF(1), VFR(7), o[3], 0, 0, 0), C, 14); \
    } while (0)
  #define ENDW(tt) do { const int d_ = NT - (tt); if (d_ >= 5) { WAIT_BAR(6); } else if (d_ == 4) { WAIT_BAR(5); } else if (d_ == 3) { WAIT_BAR(4); } else { WAIT_BAR(2); } } while (0)
  int t = 1;
  for (; t + 1 < NT; t += 2) {
    STEP(pB, pA, t);         ENDW(t);     RESC();
    STEP(pA, pB, t + 1);     ENDW(t + 1); RESC();
  }
  STEP(pB, pA, NT - 1); RESC();
  WAIT_BAR(0);
  { float sacc = pB[0] + pB[1];
    #pragma unroll
    for (int r = 2; r < 16; ++r) sacc += pB[r];
    l_reg += sacc;
    pw0 = (u32x4){PKW(pB, 0), PKW(pB, 2), PKW(pB, 4), PKW(pB, 6)}; pw1 = (u32x4){PKW(pB, 8), PKW(pB, 10), PKW(pB, 12), PKW(pB, 14)};
    SBAR();
    const lds_cptr vp_ = vp0 + VSL(NT - 1);
    VRD(0); VRD(1); VRD(2); VRD(3); VRD(4); VRD(5); VRD(6); VRD(7);
    #pragma unroll
    for (int i = 0; i < 4; ++i) o[i] = __builtin_amdgcn_mfma_f32_32x32x16_bf16(PAF(0), VFR(i), o[i], 0, 0, 0);
    #pragma unroll
    for (int i = 0; i < 4; ++i) o[i] = __builtin_amdgcn_mfma_f32_32x32x16_bf16(PAF(1), VFR(4 + i), o[i], 0, 0, 0); }
  #undef PKW
  #undef PAF
  #undef VFR
  #undef PIN
  #undef MX3
  #undef GAPA
  #undef GAPB
  #undef EX
  #undef VRD
  #undef STEP
  #undef ENDW
  #undef KLD
  #undef KSL
  #undef VSL
  { auto rr = __builtin_amdgcn_permlane32_swap(__float_as_uint(l_reg), __float_as_uint(l_reg), false, false); l_reg = __uint_as_float(rr[0]) + __uint_as_float(rr[1]); }
  float* ml = (float*)(shm + D_LDS_ML);
  if (hi == 0) { ml[wid * 64 + r32] = mhat; ml[wid * 64 + 32 + r32] = l_reg; }
  asm volatile("s_waitcnt lgkmcnt(0)\n\ts_barrier" ::: "memory");
  { const float mo = ml[(wid ^ 4) * 64 + r32], lo_ = ml[(wid ^ 4) * 64 + 32 + r32];
    const float M = fmaxf(mhat, mo), as = __builtin_amdgcn_exp2f(mhat - M), ao = __builtin_amdgcn_exp2f(mo - M);
    const float sc = as * __builtin_amdgcn_rcpf(l_reg * as + lo_ * ao);
    if (hi == 0) wsf[r32] = sc; }
  asm volatile("s_waitcnt lgkmcnt(0)" ::: "memory");
  float rli[16];
  #pragma unroll
  for (int r = 0; r < 16; ++r) rli[r] = wsf[crow(r, hi)];
  f32x16 keep0, keep1, send0, send1;
  #pragma unroll
  for (int r = 0; r < 16; ++r) { const float a0 = o[0][r] * rli[r], a1 = o[1][r] * rli[r], a2 = o[2][r] * rli[r], a3 = o[3][r] * rli[r];
    keep0[r] = kh ? a2 : a0; keep1[r] = kh ? a3 : a1; send0[r] = kh ? a0 : a2; send1[r] = kh ? a1 : a3; }
  { float* xs = (float*)(shm + D_LDS_X) + wid * 2048 + lane;
    #pragma unroll
    for (int r = 0; r < 16; ++r) { xs[r * 64] = send0[r]; xs[1024 + r * 64] = send1[r]; } }
  asm volatile("s_waitcnt lgkmcnt(0)\n\ts_barrier" ::: "memory");
  { const float* xr = (const float*)(shm + D_LDS_X) + (wid ^ 4) * 2048 + lane;
    #pragma unroll
    for (int r = 0; r < 16; ++r) { keep0[r] += xr[r * 64]; keep1[r] += xr[1024 + r * 64]; } }
  bf16* Ow = O + (long)(q0 + pr * QBLK) * po + kh * 64;
  { bf16* stg = (bf16*)(shm + D_LDS_STG) + wid * 2048;
    #pragma unroll
    for (int r = 0; r < 16; ++r) { const int orow = crow(r, hi); stg[orow * 64 + r32] = __float2bfloat16(keep0[r]); stg[orow * 64 + 32 + r32] = __float2bfloat16(keep1[r]); }
    asm volatile("s_waitcnt lgkmcnt(0)" ::: "memory");
    #pragma unroll
    for (int i = 0; i < 4; ++i) { const int row = i * 8 + (lane >> 3), ch = lane & 7; const u32x4 v = *(const u32x4*)(stg + row * 64 + ch * 8); *(__attribute__((address_space(1))) u32x4*)(void*)(Ow + (long)row * po + ch * 8) = v; } }
  asm volatile("s_waitcnt lgkmcnt(0)\n\ts_barrier" ::: "memory");
  #undef DMA_K
  #undef DMA_V
  #undef CMASK
  #undef RESC
}
template <int THRL> __device__ __forceinline__ void diff_unit2(int qb, const bf16* Q, const bf16* __restrict__ K, const bf16* __restrict__ V, bf16* O, int po, const bf16* O1, float lam, float post, const float* gain, char* shm) {
  constexpr bool BIAS = false; constexpr int W_LDS_V = NSLOT * SLOTB, W_LDS_WS = W_LDS_V + NSLOT * 16384, W_LDS_OST = 0;
  int tid_ = threadIdx.x; asm volatile("" : "+v"(tid_));
  const int tid = tid_, lane = tid & 63, r32 = lane & 31, hi = lane >> 5; const int wid = __builtin_amdgcn_readfirstlane(tid >> 6);
  const int q0 = qb * QB;
  const bf16* Qw = Q + (long)(q0 + wid * QBLK) * PQ;
  const unsigned lds0 = (unsigned)(uintptr_t)shm;
  float* wsf = (float*)(shm + W_LDS_WS) + wid * 64;
  const int NT = (q0 + QB) / KVBLK;
  const bf16* ksrc = K + (long)lane * PQ + wid * 8;
  const bf16* vsrc = V + (long)(16 * (wid & 3) + (lane >> 2)) * PQ + (wid >> 2) * 32 + (lane & 3) * 8;
  const unsigned kdst = lds0 + LDS_K + wid * 1024, vdst = lds0 + W_LDS_V + wid * 1024;
  #define DMA_K(t, slot) glds16(ksrc + (long)(t) * KVBLK * PQ, (unsigned)__builtin_amdgcn_readfirstlane(kdst + (slot)))
  #define DMA_V(t, slot) do { glds16(vsrc + (long)(t) * KVBLK * PQ, (unsigned)__builtin_amdgcn_readfirstlane(vdst + 2 * (slot))); \
                              glds16(vsrc + (long)(t) * KVBLK * PQ + 64, (unsigned)__builtin_amdgcn_readfirstlane(vdst + 2 * (slot) + 8192)); } while (0)
  const char* Kbase = shm + LDS_K; bf16x8 kf[8];
  const lds_cptr shm3 = (lds_cptr)shm; const lds_cptr kp0 = shm3 + LDS_K + hi * 1024 + r32 * 16; const lds_cptr vp0 = shm3 + W_LDS_V + ((lane >> 4) & 1) * 32 + (lane & 3) * 8 + (4 * hi + ((lane & 15) >> 2)) * 64;
  DMA_K(0, 0); DMA_V(0, 0); DMA_K(1, SLOTB);
  bf16x8 qr[4];
  #pragma unroll
  for (int d0 = 0; d0 < 4; ++d0) qr[d0] = *reinterpret_cast<const bf16x8*>(&Qw[(long)r32 * PQ + d0 * 16 + hi * 8]);
  float mhat = 0.f, l_reg = 0.f; f32x16 o[4]; o[0] = f32x16{}; o[1] = f32x16{}; o[2] = f32x16{}; o[3] = f32x16{}; f32x16 negm = f32x16{}; asm volatile("" : "+v"(negm));
  const int qrel = wid * QBLK + r32;
  #define CMASK(P0, P1, t) do { int jb_ = (t) - (NT - 4); if (jb_ >= 0) cmask(P0, P1, jb_, qrel, hi); } while (0)
  bool resc = false;
  #define START(P0, P1) do { const float rm = rowmax(P0, P1); resc = false; \
    { const float dl = rm; mhat = fadd_s(mhat, dl); \
      _Pragma("unroll") for (int r = 0; r < 16; ++r) { P0[r] = fsub_s(P0[r], dl); P1[r] = fsub_s(P1[r], dl); } \
      if (!BIAS) { _Pragma("unroll") for (int r = 0; r < 16; ++r) negm[r] = -mhat; asm volatile("" : "+v"(negm)); } } \
    _Pragma("unroll") for (int r = 0; r < 16; ++r) P0[r] = __builtin_amdgcn_exp2f(P0[r]); } while (0)
  #define RESC() do { if (resc) { asm volatile("s_waitcnt lgkmcnt(0)" ::: "memory"); \
      _Pragma("unroll") for (int r = 0; r < 16; ++r) { const float f_ = wsf[crow(r, hi)]; o[0][r] *= f_; o[1][r] *= f_; o[2][r] *= f_; o[3][r] *= f_; } } } while (0)
  f32x16 pA0, pA1, pB0, pB1;
  int sl_prev = 0, sl_cur = 0, sl_next = SLOTB;
  #define ROT() do { sl_prev = sl_cur; sl_cur = sl_next; sl_next = (sl_next == (NSLOT - 1) * SLOTB) ? 0 : sl_next + SLOTB; } while (0)
  DMA_K(2, 2 * SLOTB);
  WAIT_BAR(4);
  qkt(pA0, pA1, Kbase, qr, negm, negm, r32, hi);
  asm volatile("s_nop 15\n\ts_nop 7" : "+v"(pA0), "+v"(pA1)); CMASK(pA0, pA1, 0);
  START(pA0, pA1);
  _Pragma("unroll") for (int r = 0; r < 16; ++r) pA1[r] = __builtin_amdgcn_exp2f(pA1[r]);
  WAIT_BAR(0);
  DMA_K(3, 0); DMA_V(1, SLOTB);
  ROT();
  kload8(kf, kp0 + sl_cur);
  WAIT_BAR(3);
  s16x4 vlo[8], vhi[8]; u32x4 pw0, pw1, pw2, pw3;
  #define PKW(P, B) cvtpk_s(P[B], P[B + 1])
  #define PAF(k) __builtin_bit_cast(bf16x8, pw##k)
  #define VFR(i) (bf16x8){vlo[i][0], vlo[i][1], vlo[i][2], vlo[i][3], vhi[i][0], vhi[i][1], vhi[i][2], vhi[i][3]}
  #define PIN(x) asm volatile("" : "+v"(x))
  #define MX3(a, b, c) __builtin_fmaxf(__builtin_fmaxf((a), (b)), (c))
  #define GAPA(MF, A0, A1, A2, A3, W0, W1, PW) do { MF; sacc += A0; sacc += A1; sacc += A2; sacc += A3; PIN(sacc); W0; W1; PIN(PW); SBAR(); } while (0)
  #define EX(v) __builtin_amdgcn_exp2f(v)
  #define GAPB(MF, X, B) do { MF; X[B] = EX(X[B]); X[B + 1] = EX(X[B + 1]); X[B + 2] = EX(X[B + 2]); X[B + 3] = EX(X[B + 3]); PIN(X); SBAR(); } while (0)
  #define VRD(i) do { vlo[i] = vtr(vp_ + (((i) >> 2) * 4096 + ((i) & 3) * 1024)); vhi[i] = vtr(vp_ + (((i) >> 2) * 4096 + ((i) & 3) * 1024 + 512)); } while (0)
  #define VRD2(i) do { vlo[i] = vtr(vp_ + (8192 + ((i) >> 2) * 4096 + ((i) & 3) * 1024)); vhi[i] = vtr(vp_ + (8192 + ((i) >> 2) * 4096 + ((i) & 3) * 1024 + 512)); } while (0)
  #define KRD(G, j) do { if (G) { kload2(kf, kp0 + sl_next, j); SBAR(); } } while (0)
  #define CI0(C0) (BIAS ? C0 : negm)
  #define STEP(C0, C1, P0, P1, t, GK, GV, GL) do { SBAR(); \
    if (GK) { DMA_K((t) + 3, sl_cur); } if (GV) { DMA_V((t) + 1, sl_next); } SBAR(); \
    const lds_cptr vp_ = vp0 + 2 * sl_prev; \
    VRD(0); SBAR(); float sacc = (P0[0] + P0[1]); \
    GAPA(C0 = __builtin_amdgcn_mfma_f32_32x32x16_bf16(kf[0], qr[0], CI0(C0), 0, 0, 0), P0[2], P0[3], P0[4], P0[5],     pw0[0] = PKW(P0, 0), pw0[1] = PKW(P0, 2), pw0); \
    VRD(4); SBAR(); GAPA(C1 = __builtin_amdgcn_mfma_f32_32x32x16_bf16(kf[1], qr[0], CI0(C1), 0, 0, 0), P0[6], P0[7], P0[8], P0[9],     pw0[2] = PKW(P0, 4), pw0[3] = PKW(P0, 6), pw0); \
    VRD(1); SBAR(); GAPA(C0 = __builtin_amdgcn_mfma_f32_32x32x16_bf16(kf[2], qr[1], C0, 0, 0, 0),   P0[10], P0[11], P0[12], P0[13], pw1[0] = PKW(P0, 8), pw1[1] = PKW(P0, 10), pw1); \
    VRD(5); SBAR(); GAPA(C1 = __builtin_amdgcn_mfma_f32_32x32x16_bf16(kf[3], qr[1], C1, 0, 0, 0),   P0[14], P0[15], P1[0], P1[1],   pw1[2] = PKW(P0, 12), pw1[3] = PKW(P0, 14), pw1); \
    VRD(2); SBAR(); GAPA(C0 = __builtin_amdgcn_mfma_f32_32x32x16_bf16(kf[4], qr[2], C0, 0, 0, 0),   P1[2], P1[3], P1[4], P1[5],     pw2[0] = PKW(P1, 0), pw2[1] = PKW(P1, 2), pw2); \
    VRD(6); SBAR(); GAPA(C1 = __builtin_amdgcn_mfma_f32_32x32x16_bf16(kf[5], qr[2], C1, 0, 0, 0),   P1[6], P1[7], P1[8], P1[9],     pw2[2] = PKW(P1, 4), pw2[3] = PKW(P1, 6), pw2); \
    VRD(3); SBAR(); GAPA(C0 = __builtin_amdgcn_mfma_f32_32x32x16_bf16(kf[6], qr[3], C0, 0, 0, 0),   P1[10], P1[11], P1[12], P1[13], pw3[0] = PKW(P1, 8), pw3[1] = PKW(P1, 10), pw3); \
    VRD(7); SBAR(); GAPA(C1 = __builtin_amdgcn_mfma_f32_32x32x16_bf16(kf[7], qr[3], C1, 0, 0, 0),   P1[14], P1[15], 0.f, 0.f,       pw3[2] = PKW(P1, 12), pw3[3] = PKW(P1, 14), pw3); \
    l_reg += sacc; \
    CMASK(C0, C1, t); \
    { float a = MX3(C0[0], C0[1], C1[0]), b = MX3(C0[2], C0[3], C1[1]); a = MX3(a, C1[2], C1[3]); \
      _Pragma("unroll") for (int r = 4; r < 16; r += 4) { a = MX3(a, C0[r], C0[r + 1]); b = MX3(b, C0[r + 2], C0[r + 3]); a = MX3(a, C1[r], C1[r + 1]); b = MX3(b, C1[r + 2], C1[r + 3]); } \
      float rm = __builtin_fmaxf(a, b); { auto rr = __builtin_amdgcn_permlane32_swap(__float_as_uint(rm), __float_as_uint(rm), false, false); rm = __builtin_fmaxf(__uint_as_float(rr[0]), __uint_as_float(rr[1])); } \
      resc = false; \
      if (__builtin_expect(__any(rm > (float)THRL), 0)) { const float dl = __builtin_fmaxf(rm, 0.f); mhat += dl; \
        _Pragma("unroll") for (int r = 0; r < 16; ++r) { C0[r] -= dl; C1[r] -= dl; } \
        if (!BIAS) { _Pragma("unroll") for (int r = 0; r < 16; ++r) negm[r] = -mhat; asm volatile("" : "+v"(negm)); } \
        const float f = __builtin_amdgcn_exp2f(-dl); l_reg *= f; if (hi == 0) wsf[r32] = f; resc = true; } } \
    SBAR(); \
    GAPB(o[0] = __builtin_amdgcn_mfma_f32_32x32x16_bf16(PAF(0), VFR(0), o[0], 0, 0, 0), C0, 0); \
    GAPB(o[1] = __builtin_amdgcn_mfma_f32_32x32x16_bf16(PAF(0), VFR(4), o[1], 0, 0, 0), C0, 4); \
    KRD(GL, 0); GAPB(o[0] = __builtin_amdgcn_mfma_f32_32x32x16_bf16(PAF(1), VFR(1), o[0], 0, 0, 0), C0, 8); \
    KRD(GL, 1); GAPB(o[1] = __builtin_amdgcn_mfma_f32_32x32x16_bf16(PAF(1), VFR(5), o[1], 0, 0, 0), C0, 12); \
    KRD(GL, 2); GAPB(o[0] = __builtin_amdgcn_mfma_f32_32x32x16_bf16(PAF(2), VFR(2), o[0], 0, 0, 0), C1, 0); \
    KRD(GL, 3); GAPB(o[1] = __builtin_amdgcn_mfma_f32_32x32x16_bf16(PAF(2), VFR(6), o[1], 0, 0, 0), C1, 4); \
    VRD2(0); VRD2(4); SBAR(); \
    GAPB(o[0] = __builtin_amdgcn_mfma_f32_32x32x16_bf16(PAF(3), VFR(3), o[0], 0, 0, 0), C1, 8); \
    VRD2(1); VRD2(5); SBAR(); \
    GAPB(o[1] = __builtin_amdgcn_mfma_f32_32x32x16_bf16(PAF(3), VFR(7), o[1], 0, 0, 0), C1, 12); \
    VRD2(2); VRD2(6); SBAR(); \
    o[2] = __builtin_amdgcn_mfma_f32_32x32x16_bf16(PAF(0), VFR(0), o[2], 0, 0, 0); SBAR(); \
    o[3] = __builtin_amdgcn_mfma_f32_32x32x16_bf16(PAF(0), VFR(4), o[3], 0, 0, 0); VRD2(3); VRD2(7); SBAR(); \
    o[2] = __builtin_amdgcn_mfma_f32_32x32x16_bf16(PAF(1), VFR(1), o[2], 0, 0, 0); SBAR(); \
    o[3] = __builtin_amdgcn_mfma_f32_32x32x16_bf16(PAF(1), VFR(5), o[3], 0, 0, 0); SBAR(); \
    o[2] = __builtin_amdgcn_mfma_f32_32x32x16_bf16(PAF(2), VFR(2), o[2], 0, 0, 0); SBAR(); \
    o[3] = __builtin_amdgcn_mfma_f32_32x32x16_bf16(PAF(2), VFR(6), o[3], 0, 0, 0); SBAR(); \
    o[2] = __builtin_amdgcn_mfma_f32_32x32x16_bf16(PAF(3), VFR(3), o[2], 0, 0, 0); SBAR(); \
    o[3] = __builtin_amdgcn_mfma_f32_32x32x16_bf16(PAF(3), VFR(7), o[3], 0, 0, 0); SBAR(); \
    } while (0)
  int t = 1;
  #undef CMASK
  #define CMASK(P0, P1, t) do {} while (0)
  for (; t + 5 < NT; t += 2) {
    STEP(pB0, pB1, pA0, pA1, t, true, true, true);     WAIT_BAR(3); RESC(); ROT();
    STEP(pA0, pA1, pB0, pB1, t + 1, true, true, true); WAIT_BAR(3); RESC(); ROT();
  }
  #undef CMASK
  #define CMASK(P0, P1, t) do { int jb_ = (t) - (NT - 4); if (jb_ >= 0) cmask(P0, P1, jb_, qrel, hi); } while (0)
  #define ENDW(tt) do { if ((tt) + 3 < NT) { WAIT_BAR(3); } else if ((tt) + 2 < NT) { WAIT_BAR(2); } else { WAIT_BAR(0); } } while (0)
  for (; t + 1 < NT; t += 2) {
    STEP(pB0, pB1, pA0, pA1, t, (t + 3 < NT), (t + 1 < NT), (t + 1 < NT));         ENDW(t);     RESC(); ROT();
    STEP(pA0, pA1, pB0, pB1, t + 1, (t + 4 < NT), (t + 2 < NT), (t + 2 < NT));     ENDW(t + 1); RESC(); ROT();
  }
  STEP(pB0, pB1, pA0, pA1, NT - 1, false, false, false); RESC();
  { float sacc = pB0[0] + pB0[1]; _Pragma("unroll") for (int r = 2; r < 16; ++r) sacc += pB0[r]; _Pragma("unroll") for (int r = 0; r < 16; ++r) sacc += pB1[r]; l_reg += sacc;
    pw0 = (u32x4){PKW(pB0, 0), PKW(pB0, 2), PKW(pB0, 4), PKW(pB0, 6)}; pw1 = (u32x4){PKW(pB0, 8), PKW(pB0, 10), PKW(pB0, 12), PKW(pB0, 14)}; pw2 = (u32x4){PKW(pB1, 0), PKW(pB1, 2), PKW(pB1, 4), PKW(pB1, 6)}; pw3 = (u32x4){PKW(pB1, 8), PKW(pB1, 10), PKW(pB1, 12), PKW(pB1, 14)};
    SBAR();
    { const lds_cptr vp_ = vp0 + 2 * sl_cur;
      VRD(0); VRD(1); VRD(2); VRD(3); VRD(4); VRD(5); VRD(6); VRD(7);
      o[0] = __builtin_amdgcn_mfma_f32_32x32x16_bf16(PAF(0), VFR(0), o[0], 0, 0, 0); o[1] = __builtin_amdgcn_mfma_f32_32x32x16_bf16(PAF(0), VFR(4), o[1], 0, 0, 0);
      o[0] = __builtin_amdgcn_mfma_f32_32x32x16_bf16(PAF(1), VFR(1), o[0], 0, 0, 0); o[1] = __builtin_amdgcn_mfma_f32_32x32x16_bf16(PAF(1), VFR(5), o[1], 0, 0, 0);
      o[0] = __builtin_amdgcn_mfma_f32_32x32x16_bf16(PAF(2), VFR(2), o[0], 0, 0, 0); o[1] = __builtin_amdgcn_mfma_f32_32x32x16_bf16(PAF(2), VFR(6), o[1], 0, 0, 0);
      o[0] = __builtin_amdgcn_mfma_f32_32x32x16_bf16(PAF(3), VFR(3), o[0], 0, 0, 0); o[1] = __builtin_amdgcn_mfma_f32_32x32x16_bf16(PAF(3), VFR(7), o[1], 0, 0, 0);
      SBAR();
      VRD2(0); VRD2(1); VRD2(2); VRD2(3); VRD2(4); VRD2(5); VRD2(6); VRD2(7);
      o[2] = __builtin_amdgcn_mfma_f32_32x32x16_bf16(PAF(0), VFR(0), o[2], 0, 0, 0); o[3] = __builtin_amdgcn_mfma_f32_32x32x16_bf16(PAF(0), VFR(4), o[3], 0, 0, 0);
      o[2] = __builtin_amdgcn_mfma_f32_32x32x16_bf16(PAF(1), VFR(1), o[2], 0, 0, 0); o[3] = __builtin_amdgcn_mfma_f32_32x32x16_bf16(PAF(1), VFR(5), o[3], 0, 0, 0);
      o[2] = __builtin_amdgcn_mfma_f32_32x32x16_bf16(PAF(2), VFR(2), o[2], 0, 0, 0); o[3] = __builtin_amdgcn_mfma_f32_32x32x16_bf16(PAF(2), VFR(6), o[3], 0, 0, 0);
      o[2] = __builtin_amdgcn_mfma_f32_32x32x16_bf16(PAF(3), VFR(3), o[2], 0, 0, 0); o[3] = __builtin_amdgcn_mfma_f32_32x32x16_bf16(PAF(3), VFR(7), o[3], 0, 0, 0); } }
  #undef PKW
  #undef PAF
  #undef VFR
  #undef PIN
  #undef MX3
  #undef GAPA
  #undef GAPB
  #undef EX
  #undef VRD
  #undef VRD2
  #undef KRD
  #undef STEP
  #undef ENDW
  #undef CI0
  { auto rr = __builtin_amdgcn_permlane32_swap(__float_as_uint(l_reg), __float_as_uint(l_reg), false, false); l_reg = __uint_as_float(rr[0]) + __uint_as_float(rr[1]); }
  if (hi == 0) wsf[32 + r32] = l_reg; asm volatile("s_waitcnt lgkmcnt(0)" ::: "memory");
  float rli[16];
  #pragma unroll
  for (int r = 0; r < 16; ++r) rli[r] = __builtin_amdgcn_rcpf(wsf[32 + crow(r, hi)]);
  bf16* Ow = O + (long)(q0 + wid * QBLK) * po;
  asm volatile("s_waitcnt lgkmcnt(0)\n\ts_barrier" ::: "memory");
  { bf16* stg = (bf16*)(shm + W_LDS_OST) + wid * 4096;
    #pragma unroll
    for (int r = 0; r < 16; ++r) { const int orow = crow(r, hi);
      #pragma unroll
      for (int d0 = 0; d0 < 4; ++d0) stg[orow * 128 + d0 * 32 + r32] = __float2bfloat16(o[d0][r] * rli[r]); }
    asm volatile("s_waitcnt lgkmcnt(0)" ::: "memory");
    if (O1 == nullptr) {
      #pragma unroll
      for (int i = 0; i < 8; ++i) { const int row = i * 4 + (lane >> 4), ch = lane & 15; const u32x4 v = *(const u32x4*)(stg + row * 128 + ch * 8); *(__attribute__((address_space(1))) u32x4*)(void*)(Ow + (long)row * po + ch * 8) = v; }
    } else {
      const bf16* O1w = O1 + (long)(q0 + wid * QBLK) * 512; const int ch = lane & 15;
      const f32x4 g0 = *(const f32x4*)(gain + ch * 8), g1 = *(const f32x4*)(gain + ch * 8 + 4);
      #pragma unroll
      for (int i = 0; i < 8; ++i) { const int row = i * 4 + (lane >> 4); const u32x4 v2 = *(const u32x4*)(stg + row * 128 + ch * 8);
        const u32x4 v1 = *(const __attribute__((address_space(1))) u32x4*)(const void*)(O1w + (long)row * 512 + ch * 8);
        float d[8];
        d[0] = pg8::bf_lo(v1.x) - lam * pg8::bf_lo(v2.x); d[1] = pg8::bf_hi(v1.x) - lam * pg8::bf_hi(v2.x); d[2] = pg8::bf_lo(v1.y) - lam * pg8::bf_lo(v2.y); d[3] = pg8::bf_hi(v1.y) - lam * pg8::bf_hi(v2.y);
        d[4] = pg8::bf_lo(v1.z) - lam * pg8::bf_lo(v2.z); d[5] = pg8::bf_hi(v1.z) - lam * pg8::bf_hi(v2.z); d[6] = pg8::bf_lo(v1.w) - lam * pg8::bf_lo(v2.w); d[7] = pg8::bf_hi(v1.w) - lam * pg8::bf_hi(v2.w);
        float ss = 0.f;
        #pragma unroll
        for (int k = 0; k < 8; ++k) ss += d[k] * d[k];
        ss += __shfl_xor(ss, 1); ss += __shfl_xor(ss, 2); ss += __shfl_xor(ss, 4); ss += __shfl_xor(ss, 8);
        const float rr_ = rsqrtf(ss * (1.f / 128.f) + SUBLN_EPS) * post;
        u32x4 w; w.x = pg8::cvt_pk(d[0] * rr_ * g0[0], d[1] * rr_ * g0[1]); w.y = pg8::cvt_pk(d[2] * rr_ * g0[2], d[3] * rr_ * g0[3]); w.z = pg8::cvt_pk(d[4] * rr_ * g1[0], d[5] * rr_ * g1[1]); w.w = pg8::cvt_pk(d[6] * rr_ * g1[2], d[7] * rr_ * g1[3]);
        *(__attribute__((address_space(1))) u32x4*)(void*)(Ow + (long)row * po + ch * 8) = w; }
    } }
  asm volatile("s_waitcnt lgkmcnt(0)\n\ts_barrier" ::: "memory");
  #undef DMA_K
  #undef DMA_V
  #undef CMASK
  #undef START
  #undef RESC
  #undef ROT
}
#undef SBAR
#undef WAIT_BAR
}

#ifndef MK_DENSE8
#define MK_DENSE8 2
#endif
constexpr size_t MiB = 1ull << 20;
constexpr size_t WS_CTL = 0, CTL_ZERO_BYTES = 1 * MiB;
constexpr size_t WS_SSQ = 926 * MiB;
constexpr size_t WS_LOGF = 2 * MiB, WS_CS2 = 4 * MiB, WS_COS = 6 * MiB, WS_SIN = 8 * MiB;
constexpr size_t WS_ROUTE = 10 * MiB;
constexpr size_t RT_CHOICE = WS_ROUTE, RT_GATES = WS_ROUTE + 256 * 1024, RT_CNT = WS_ROUTE + 768 * 1024, RT_TOK = WS_ROUTE + 1 * MiB, RT_GATE_S = WS_ROUTE + 2 * MiB, RT_TEXP = WS_ROUTE + 3 * MiB, RT_NT = RT_TEXP + 4096;
constexpr size_t WS_MEMN = 16 * MiB, WS_KM = 32 * MiB, WS_VT = 48 * MiB, WS_H = 64 * MiB;
constexpr size_t WS_WIN = 192 * MiB, WS_WOUT = 220 * MiB, WS_WMQ = 228 * MiB, WS_WMO = 236 * MiB, WS_WMKV = 244 * MiB, WS_WFF13 = 260 * MiB, WS_WFF2 = 282 * MiB, WS_WRT = 294 * MiB;
constexpr size_t WS_WE13 = 296 * MiB, WS_WE2 = 408 * MiB, WS_R = 464 * MiB, WS_H8 = 938 * MiB, WS_END = 1002 * MiB, WS_MT = WS_R + 400 * MiB, WS_VWT = WS_R + 416 * MiB;
constexpr size_t OUT_O1 = 0, OUT_O2 = 64 * MiB, OUT_MIX = 128 * MiB;
constexpr int CW_BAR = 4096, CW_KMX = 8192;
static_assert(WS_R + (size_t)MOE_ROWS * D_EXP * 2 <= WS_SSQ && WS_R + (size_t)T * QKVP * 2 <= WS_SSQ && WS_SSQ + (size_t)3 * T * 16 * 4 <= WS_H8 && WS_H8 + (size_t)T * DM <= WS_END, "R region");

constexpr int NWAVES = 8;
constexpr int RING_BYTES = 131072, LDSCTL_OFF = RING_BYTES, MISC_OFF = LDSCTL_OFF + 320, LDSX_OFF = RING_BYTES + 1024, LDSH_OFF = LDSX_OFF + 8192, LDSR_OFF = LDSH_OFF + 64;
constexpr int LDS_BYTES = 147456;
static_assert(LDSR_OFF + 2048 <= LDS_BYTES, "LDS map");
static_assert(attn_body::LDS_BYTES <= RING_BYTES && attn_body::D_LDS_BYTES <= RING_BYTES, "attention scratch inside the ring region");

#define GAS __attribute__((address_space(1)))
#define LAS __attribute__((address_space(3)))
typedef unsigned short bf16;
typedef unsigned v4u __attribute__((ext_vector_type(4)));
typedef float f32x4 __attribute__((ext_vector_type(4)));
typedef GAS unsigned gu32;
#define RLX_AGENT __ATOMIC_RELAXED, __HIP_MEMORY_SCOPE_AGENT
#define LDS_WAIT() asm volatile("s_waitcnt lgkmcnt(0)" ::: "memory")

#define XB_TMO      128
#define XB_XCNT(j)  (256  + 64 * (j))
#define XB_XSUB(j)  (1280 + 64 * (j))
#define XB_XGEN(j)  (2304 + 64 * (j))
#define XB_TOP      3328
#define XB_TOPGEN   3392
#define XCD_BAR_WORDS 3456
#define XB_SPIN_CAP (1u << 18)
__device__ __forceinline__ unsigned xb_ld(unsigned* p)              { return __hip_atomic_load(p, __ATOMIC_RELAXED, __HIP_MEMORY_SCOPE_AGENT); }
__device__ __forceinline__ unsigned xb_add(unsigned* p, unsigned v) { return __hip_atomic_fetch_add(p, v, __ATOMIC_RELAXED, __HIP_MEMORY_SCOPE_AGENT); }
__device__ __forceinline__ unsigned xb_xcc_id() { return (unsigned)__builtin_amdgcn_s_getreg((3 << 11) | 20) & 0xFu; }
#define XB_SPIN(cond, bar) do { unsigned _sp = 0; while (cond) { __builtin_amdgcn_s_sleep(1); \
    if ((++_sp & 255u) == 0u) { if (xb_ld(&(bar)[XB_TMO])) break; if (_sp > XB_SPIN_CAP) { atomicAdd(&(bar)[XB_TMO], 1u); break; } } } } while (0)
struct XcdBarrier { unsigned* bar; unsigned x; volatile LAS unsigned* st; };
__device__ __forceinline__ XcdBarrier xcd_barrier_post(unsigned* bar, volatile LAS unsigned* st) {
    XcdBarrier b; b.bar = bar; b.x = xb_xcc_id(); b.st = st;
    if (threadIdx.x == 0) (void)xb_add(&bar[XB_XCNT(b.x)], 1u);
    return b;
}
__device__ __forceinline__ void xcd_barrier_complete(unsigned* bar, unsigned x, unsigned& nloc, unsigned& nx) {
    const unsigned G = gridDim.x * gridDim.y * gridDim.z;
    unsigned sum, cnt, mine, sp = 0u;
    for (;;) {
        sum = 0u; cnt = 0u; mine = 0u;
#pragma unroll
        for (unsigned j = 0; j < 16; ++j) { const unsigned c = xb_ld(&bar[XB_XCNT(j)]); sum += c; cnt += (c > 0u) ? 1u : 0u; mine = (j == x) ? c : mine; }
        if (sum == G) break;
        __builtin_amdgcn_s_sleep(1);
        if ((++sp & 255u) == 0u) { if (xb_ld(&bar[XB_TMO])) break; if (sp > XB_SPIN_CAP) { atomicAdd(&bar[XB_TMO], 1u); break; } }
    }
    nloc = mine > 0u ? mine : 1u; nx = cnt > 0u ? cnt : 1u;
}
__device__ __forceinline__ void xcd_barrier(const XcdBarrier& b) {
    asm volatile("s_waitcnt vmcnt(0)" ::: "memory");
    __syncthreads();
    if (threadIdx.x == 0) {
        unsigned* bar = b.bar;
        __builtin_amdgcn_s_waitcnt(0);
        unsigned nloc = b.st[0], nx = b.st[1];
        if (nloc == 0u) { xcd_barrier_complete(bar, b.x, nloc, nx); b.st[0] = nloc; b.st[1] = nx; }
        const unsigned old = xb_add(&bar[XB_XSUB(b.x)], 1u);
        const unsigned gen = old / nloc;
        if (old + 1u == (gen + 1u) * nloc) {
            __builtin_amdgcn_fence(__ATOMIC_RELEASE, "agent");
            asm volatile("s_waitcnt vmcnt(0)" ::: "memory");
            const unsigned og = xb_add(&bar[XB_TOP], 1u);
            const unsigned tg = og / nx;
            if (og + 1u == (tg + 1u) * nx) xb_add(&bar[XB_TOPGEN], 1u);
            else XB_SPIN(xb_ld(&bar[XB_TOPGEN]) == tg, bar);
            __builtin_amdgcn_fence(__ATOMIC_ACQUIRE, "agent");
            xb_add(&bar[XB_XGEN(b.x)], 1u);
            asm volatile("s_waitcnt vmcnt(0)" ::: "memory");
        } else {
            XB_SPIN(xb_ld(&bar[XB_XGEN(b.x)]) == gen, bar);
            __builtin_amdgcn_fence(__ATOMIC_ACQUIRE, "agent");
            asm volatile("s_waitcnt vmcnt(0)" ::: "memory");
        }
    }
    __syncthreads();
}

struct Args { const void* in[26]; float* out; unsigned char* ws; int ph_lo, ph_hi; };
struct Ctx {
    LAS unsigned char* lds; int tid, lane, wave, vcu, G;
    const Args* a; unsigned char* ws; unsigned char* ob;
};
#define INF(i) ((const float*)A.in[i])

__device__ __forceinline__ float wave_sum(float v, int lane) {
#pragma unroll
    for (int o = 1; o < 64; o <<= 1) v += __int_as_float(__builtin_amdgcn_ds_bpermute((lane ^ o) << 2, __float_as_int(v)));
    return v;
}
__device__ __forceinline__ unsigned pk2(float lo, float hi) { return pg8::cvt_pk(lo, hi); }

__device__ __forceinline__ void conv_item(const float* src, int ldsrc, int n0s, int nvalid, int k0, const float* g, bf16* dst, int lddst, int n0d, LAS float* scr, int lane) {
    const int n = lane & 31;
#pragma unroll 8
    for (int i = 0; i < 32; ++i) { const int kk = 2 * i + (lane >> 5); float v = 0.f; if (n < nvalid) v = src[(size_t)(k0 + kk) * ldsrc + n0s + n]; if (g) v *= g[k0 + kk]; scr[kk * 33 + n] = v; }
    LDS_WAIT(); asm volatile("" ::: "memory");
    const int c = lane & 7;
#pragma unroll
    for (int j = 0; j < 4; ++j) { const int nn = (lane >> 3) + 8 * j; const LAS float* s = scr + (8 * c) * 33 + nn;
        v4u o; o.x = pk2(s[0 * 33], s[1 * 33]); o.y = pk2(s[2 * 33], s[3 * 33]); o.z = pk2(s[4 * 33], s[5 * 33]); o.w = pk2(s[6 * 33], s[7 * 33]);
        *(GAS v4u*)(dst + (size_t)(n0d + nn) * lddst + k0 + 8 * c) = o; }
    LDS_WAIT(); asm volatile("" ::: "memory");
}
__device__ __forceinline__ void conv_item_f8(const float* src, int ldsrc, int n0s, int k0, const float* g, float sc, unsigned char* dst, int lddst, int n0d, LAS float* scr, int lane) {
    const int n = lane & 31;
#pragma unroll 8
    for (int i = 0; i < 32; ++i) { const int kk = 2 * i + (lane >> 5); float v = src[(size_t)(k0 + kk) * ldsrc + n0s + n] * sc; if (g) v *= g[k0 + kk]; scr[kk * 33 + n] = v; }
    LDS_WAIT(); asm volatile("" ::: "memory");
    const int c = lane & 3;
#pragma unroll
    for (int j = 0; j < 2; ++j) { const int nn = (lane >> 2) + 16 * j; const LAS float* s = scr + (16 * c) * 33 + nn;
        v4u o; o.x = pg8::pk_fp8x4(s[0 * 33], s[1 * 33], s[2 * 33], s[3 * 33]); o.y = pg8::pk_fp8x4(s[4 * 33], s[5 * 33], s[6 * 33], s[7 * 33]);
        o.z = pg8::pk_fp8x4(s[8 * 33], s[9 * 33], s[10 * 33], s[11 * 33]); o.w = pg8::pk_fp8x4(s[12 * 33], s[13 * 33], s[14 * 33], s[15 * 33]);
        *(GAS v4u*)(dst + (size_t)(n0d + nn) * lddst + k0 + 16 * c) = o; }
    LDS_WAIT(); asm volatile("" ::: "memory");
}
struct ConvJob { const float* src; const float* src2; const float* g; bf16* dst; int ldsrc, nsrc, K, Ndst, mode, nb0; };
__device__ __forceinline__ void conv_job(const ConvJob& J, int& off, int gw, int NGW, LAS float* scr, int lane) {
    const int nblk = J.Ndst / 32 - J.nb0, n = (J.K / 64) * nblk;
    for (int it = (gw + NGW - off) % NGW; it < n; it += NGW) {
        const int kb = it / nblk, nb = J.nb0 + it % nblk, n0d = 32 * nb;
        if (J.mode == 1) { const int j = n0d >> 8, w = n0d & 255; const long dsel = (w < 128) ? 0l : (long)(J.src2 - J.src); conv_item(J.src + dsel, J.ldsrc, j * 128 + (w & 127), 32, 64 * kb, J.g, J.dst, J.K, n0d, scr, lane); }
        else { int nv = J.nsrc - n0d; nv = nv < 0 ? 0 : (nv > 32 ? 32 : nv); conv_item(J.src, J.ldsrc, n0d, nv, 64 * kb, J.g, J.dst, J.K, n0d, scr, lane); }
    }
    off = (off + n) % NGW;
}

template <bool F8> __device__ __forceinline__ void conv_tile(const float* sA, const float* sB, int ldsrc, int k0, const float* g, float sc, unsigned char* dst, int lddst, int n0d, LAS float* tile, int tid) {
    const int lane = tid & 63, wave = tid >> 6;
    const float* sp = (lane < 32 ? sA : sB) + 4 * (lane & 31);
#pragma unroll
    for (int i = 0; i < 8; ++i) { const int kk = wave + 8 * i; f32x4 v = *(const GAS f32x4*)(sp + (size_t)(k0 + kk) * ldsrc); const float gg = (g ? g[k0 + kk] : 1.f) * sc;
        *(LAS f32x4*)(tile + kk * 260 + 4 * lane) = v * gg; }
    __syncthreads();
    const int n = tid >> 1, half = tid & 1; const LAS float* tp = tile + (32 * half) * 260 + n;
    if constexpr (F8) {
    v4u o0, o1;
    o0.x = pg8::pk_fp8x4(tp[0 * 260], tp[1 * 260], tp[2 * 260], tp[3 * 260]);     o0.y = pg8::pk_fp8x4(tp[4 * 260], tp[5 * 260], tp[6 * 260], tp[7 * 260]);
    o0.z = pg8::pk_fp8x4(tp[8 * 260], tp[9 * 260], tp[10 * 260], tp[11 * 260]);   o0.w = pg8::pk_fp8x4(tp[12 * 260], tp[13 * 260], tp[14 * 260], tp[15 * 260]);
    o1.x = pg8::pk_fp8x4(tp[16 * 260], tp[17 * 260], tp[18 * 260], tp[19 * 260]); o1.y = pg8::pk_fp8x4(tp[20 * 260], tp[21 * 260], tp[22 * 260], tp[23 * 260]);
    o1.z = pg8::pk_fp8x4(tp[24 * 260], tp[25 * 260], tp[26 * 260], tp[27 * 260]); o1.w = pg8::pk_fp8x4(tp[28 * 260], tp[29 * 260], tp[30 * 260], tp[31 * 260]);
    GAS v4u* dp = (GAS v4u*)(dst + (size_t)(n0d + n) * lddst + k0 + 32 * half);
    dp[0] = o0; dp[1] = o1;
    } else {
    GAS v4u* dp = (GAS v4u*)(dst + (size_t)(n0d + n) * lddst + (k0 + 32 * half) * 2);
#pragma unroll
    for (int q = 0; q < 4; ++q) { const LAS float* t8 = tp + (8 * q) * 260;
        v4u o; o.x = pk2(t8[0 * 260], t8[1 * 260]); o.y = pk2(t8[2 * 260], t8[3 * 260]); o.z = pk2(t8[4 * 260], t8[5 * 260]); o.w = pk2(t8[6 * 260], t8[7 * 260]); dp[q] = o; }
    }
    __syncthreads();
}
struct ConvArgs { const float* sA; const float* sB; int ldsrc, k0; const float* g; float sc; unsigned char* dst; int lddst, n0d; bool f8; };
struct ConvRegs { f32x4 v[8]; float gg[8]; };
__device__ __forceinline__ void conv_issue(ConvRegs& R, const ConvArgs& a, int tid) {
    const int lane = tid & 63, wave = tid >> 6; const long dAB = a.sB - a.sA; const float* sp = a.sA + (lane < 32 ? 0L : dAB) + 4 * (lane & 31);
#pragma unroll
    for (int i = 0; i < 8; ++i) { const int kk = wave + 8 * i; R.v[i] = *(const GAS f32x4*)(sp + (size_t)(a.k0 + kk) * a.ldsrc); R.gg[i] = a.g ? a.g[a.k0 + kk] : 1.f; }
}
__device__ __forceinline__ void conv_finish(const ConvRegs& R, const ConvArgs& a, LAS float* tile, int tid) {
    const int lane = tid & 63, wave = tid >> 6;
#pragma unroll
    for (int i = 0; i < 8; ++i) { const int kk = wave + 8 * i; *(LAS f32x4*)(tile + kk * 260 + 4 * lane) = R.v[i] * (R.gg[i] * a.sc); }
    __syncthreads();
    const int n = tid >> 1, half = tid & 1; const LAS float* tp = tile + (32 * half) * 260 + n;
    if (a.f8) {
    v4u o0, o1;
    o0.x = pg8::pk_fp8x4(tp[0 * 260], tp[1 * 260], tp[2 * 260], tp[3 * 260]);     o0.y = pg8::pk_fp8x4(tp[4 * 260], tp[5 * 260], tp[6 * 260], tp[7 * 260]);
    o0.z = pg8::pk_fp8x4(tp[8 * 260], tp[9 * 260], tp[10 * 260], tp[11 * 260]);   o0.w = pg8::pk_fp8x4(tp[12 * 260], tp[13 * 260], tp[14 * 260], tp[15 * 260]);
    o1.x = pg8::pk_fp8x4(tp[16 * 260], tp[17 * 260], tp[18 * 260], tp[19 * 260]); o1.y = pg8::pk_fp8x4(tp[20 * 260], tp[21 * 260], tp[22 * 260], tp[23 * 260]);
    o1.z = pg8::pk_fp8x4(tp[24 * 260], tp[25 * 260], tp[26 * 260], tp[27 * 260]); o1.w = pg8::pk_fp8x4(tp[28 * 260], tp[29 * 260], tp[30 * 260], tp[31 * 260]);
    GAS v4u* dp = (GAS v4u*)(a.dst + (size_t)(a.n0d + n) * a.lddst + a.k0 + 32 * half);
    dp[0] = o0; dp[1] = o1;
    } else {
    GAS v4u* dp = (GAS v4u*)(a.dst + (size_t)(a.n0d + n) * a.lddst + (a.k0 + 32 * half) * 2);
#pragma unroll
    for (int q = 0; q < 4; ++q) { const LAS float* t8 = tp + (8 * q) * 260;
        v4u o; o.x = pk2(t8[0 * 260], t8[1 * 260]); o.y = pk2(t8[2 * 260], t8[3 * 260]); o.z = pk2(t8[4 * 260], t8[5 * 260]); o.w = pk2(t8[6 * 260], t8[7 * 260]); dp[q] = o; }
    }
    __syncthreads();
}
#define CONV_PIPE(it0_, n_, step_, ARGS) do { int it_ = (it0_); const int n__ = (n_), st_ = (step_); if (it_ < n__) { ConvRegs R0_, R1_; { const ConvArgs a_ = ARGS(it_); conv_issue(R0_, a_, F.tid); } \
        for (; it_ < n__; it_ += 2 * st_) { \
            if (it_ + st_ < n__) { const ConvArgs a_ = ARGS(it_ + st_); conv_issue(R1_, a_, F.tid); } \
            { const ConvArgs a_ = ARGS(it_); conv_finish(R0_, a_, tile, F.tid); } \
            if (it_ + st_ < n__) { if (it_ + 2 * st_ < n__) { const ConvArgs a_ = ARGS(it_ + 2 * st_); conv_issue(R0_, a_, F.tid); } \
                { const ConvArgs a_ = ARGS(it_ + st_); conv_finish(R1_, a_, tile, F.tid); } } } } } while (0)
__device__ __forceinline__ void p0_prologue(Ctx& F) {
    const Args& A = *F.a;
    LAS float* scr = (LAS float*)(F.lds + F.wave * 16384);
    const int gw = F.vcu * NWAVES + F.wave, NGW = F.G * NWAVES;
    { bf16* H = (bf16*)(F.ws + WS_H); float* ssq = (float*)(F.ws + WS_SSQ); const float* x = INF(0);
      for (int m0 = gw * 4; m0 < T; m0 += NGW * 4) {
          f32x4 v[4][4]; float ss[4] = {0.f, 0.f, 0.f, 0.f};
#pragma unroll
          for (int r = 0; r < 4; ++r) { const GAS f32x4* xr = (const GAS f32x4*)(x + (size_t)(m0 + r) * DM) + F.lane;
#pragma unroll
              for (int j = 0; j < 4; ++j) v[r][j] = xr[64 * j]; }
#pragma unroll
          for (int r = 0; r < 4; ++r) { GAS unsigned long long* o8 = (GAS unsigned long long*)(H + (size_t)(m0 + r) * DM) + F.lane;
#pragma unroll
              for (int j = 0; j < 4; ++j) { const unsigned a = pk2(v[r][j].x, v[r][j].y), b = pk2(v[r][j].z, v[r][j].w); o8[64 * j] = (unsigned long long)a | ((unsigned long long)b << 32);
                  ss[r] += pg8::bf_lo(a) * pg8::bf_lo(a) + pg8::bf_hi(a) * pg8::bf_hi(a) + pg8::bf_lo(b) * pg8::bf_lo(b) + pg8::bf_hi(b) * pg8::bf_hi(b); } }
          ss[0] = wave_sum(ss[0], F.lane); ss[1] = wave_sum(ss[1], F.lane); ss[2] = wave_sum(ss[2], F.lane); ss[3] = wave_sum(ss[3], F.lane);
#pragma unroll
          for (int r = 0; r < 4; ++r) if (F.lane < 16) ssq[(size_t)(m0 + r) * 16 + F.lane] = F.lane == 0 ? ss[r] : 0.f; } }
    { float* cs = (float*)(F.ws + WS_COS); float* sn = (float*)(F.ws + WS_SIN); const int* pos = (const int*)A.in[2];
      for (int idx = (F.vcu * NWAVES * 64) + F.tid; idx < T * 8; idx += F.G * NWAVES * 64) { const int t = idx >> 3, i = idx & 7;
          const float inv = (float)pow(500000.0, -(double)i / 8.0); const float ang = (float)pos[t] * inv; float s, c; sincosf(ang, &s, &c); cs[idx] = c; sn[idx] = s; } }
    { bf16* MN = (bf16*)(F.ws + WS_MEMN); const float* mem = INF(1); const float* g = INF(13);
      for (int m = gw; m < NB * NMEM; m += NGW) { const GAS f32x4* xr = (const GAS f32x4*)(mem + (size_t)m * DM) + F.lane; f32x4 v[4]; float ss = 0.f;
#pragma unroll
          for (int j = 0; j < 4; ++j) { v[j] = xr[64 * j]; ss += (v[j].x * v[j].x + v[j].y * v[j].y) + (v[j].z * v[j].z + v[j].w * v[j].w); }
          const float rs = rsqrtf(wave_sum(ss, F.lane) * (1.f / DM) + EPS);
#pragma unroll
          for (int l = 0; l < DEPTH; ++l) { GAS unsigned long long* o8 = (GAS unsigned long long*)(MN + ((size_t)l * NB * NMEM + m) * DM) + F.lane;
#pragma unroll
              for (int j = 0; j < 4; ++j) { const f32x4 gg = *((const GAS f32x4*)(g + l * DM) + F.lane + 64 * j);
                  o8[64 * j] = (unsigned long long)pk2(v[j].x * rs * gg.x, v[j].y * rs * gg.y) | ((unsigned long long)pk2(v[j].z * rs * gg.z, v[j].w * rs * gg.w) << 32); } } } }
    { bf16* WQ = (bf16*)(F.ws + WS_WMQ); const float* w = INF(14); const float* g = INF(12);
      for (int i8 = (F.vcu * NWAVES * 64) + F.tid; i8 < DEPTH * DM * DM / 8; i8 += F.G * NWAVES * 64) { const int row = i8 / (DM / 8);
          const f32x4 a = *(const GAS f32x4*)(w + (size_t)i8 * 8), b = *(const GAS f32x4*)(w + (size_t)i8 * 8 + 4); const float gg = g[row];
          v4u o; o.x = pk2(a.x * gg, a.y * gg); o.y = pk2(a.z * gg, a.w * gg); o.z = pk2(b.x * gg, b.y * gg); o.w = pk2(b.z * gg, b.w * gg);
          *(GAS v4u*)(WQ + (size_t)i8 * 8) = o; } }
    { LAS float* tile = (LAS float*)(F.lds);
      auto dense_args = [&](int idx) -> ConvArgs {
          ConvArgs a;
          if (idx < DEPTH * 448) { const int l = idx / 448, r = idx % 448;
              if (r < 192) { const int kb = r / 12, j = r % 12; const float* w = INF(4) + (size_t)l * DM * D_IN + j * 256;
                  a = ConvArgs{w, w + 128, D_IN, 64 * kb, INF(3) + l * DM, 1.f, F.ws + WS_WIN + (size_t)l * D_INP * DM * 2, DM * 2, j * 256, false}; }
              else if (r < 256) { const int r2 = r - 192, kb = r2 / 4, j = r2 % 4; const float* w = INF(11) + (size_t)l * DM * DM + j * 256;
                  a = ConvArgs{w, w + 128, DM, 64 * kb, nullptr, 1.f, F.ws + WS_WOUT + (size_t)l * DM * DM * 2, DM * 2, j * 256, false}; }
              else if (r < 384) { const int r2 = r - 256, kb = r2 / 8, j = r2 % 8; const float* w = INF(15) + (size_t)l * DM * 2 * DM + j * 256;
                  a = ConvArgs{w, w + 128, 2 * DM, 64 * kb, nullptr, 1.f, F.ws + WS_WMKV + (size_t)l * 2 * DM * DM * 2, DM * 2, j * 256, false}; }
              else { const int r2 = r - 384, kb = r2 / 4, j = r2 % 4; const float* w = INF(16) + (size_t)l * DM * DM + j * 256;
                  a = ConvArgs{w, w + 128, DM, 64 * kb, nullptr, 1.f, F.ws + WS_WMO + (size_t)l * DM * DM * 2, DM * 2, j * 256, false}; } }
          else { const int x2 = idx - DEPTH * 448, i = x2 / 528, r = x2 % 528; const bool f8 = (MK_DENSE8 >> i) & 1;
              unsigned char* d13 = F.ws + WS_WFF13 + (size_t)i * 2 * D_FF * DM * 2; unsigned char* d2 = F.ws + WS_WFF2 + (size_t)i * DM * D_FF * 2;
              if (r < 352) { const int kb = r / 22, j = r % 22; const float* w1 = INF(18) + (size_t)i * DM * D_FF + j * 128; const float* w3 = INF(19) + (size_t)i * DM * D_FF + j * 128;
                  a = ConvArgs{w1, w3, D_FF, 64 * kb, INF(17) + (2 * i) * DM, f8 ? pg8::F8_W1 : 1.f, d13, f8 ? DM : DM * 2, j * 256, f8}; }
              else { const int r2 = r - 352, kb = r2 / 4, j = r2 % 4; const float* w2 = INF(20) + (size_t)i * D_FF * DM + j * 256;
                  a = ConvArgs{w2, w2 + 128, DM, 64 * kb, nullptr, f8 ? pg8::F8_W2 : 1.f, d2, f8 ? D_FF : D_FF * 2, j * 256, f8}; } }
          return a; };
      static_assert(2 * D_FF / 256 == 22 && D_FF / 64 == 44 && D_IN / 256 == 12, "flat tile list");
#define DENSE_ARGS(it) dense_args(it)
      CONV_PIPE(F.vcu, DEPTH * 448 + 2 * 528, F.G, DENSE_ARGS);
#undef DENSE_ARGS
    }
    int off = 0;
    for (int l = 0; l < DEPTH; ++l) { ConvJob J{INF(4) + (size_t)l * DM * D_IN, nullptr, INF(3) + l * DM, (bf16*)(F.ws + WS_WIN) + (size_t)l * D_INP * DM, D_IN, D_IN, DM, D_INP, 0, 96}; conv_job(J, off, gw, NGW, scr, F.lane); }
    for (int i = 0; i < 2; ++i) { ConvJob J{INF(21) + (size_t)i * DM * NEXP, nullptr, INF(17) + (2 * i + 1) * DM, (bf16*)(F.ws + WS_WRT) + (size_t)i * 256 * DM, NEXP, NEXP, DM, 256, 0, 0}; conv_job(J, off, gw, NGW, scr, F.lane); }
}
__device__ __forceinline__ void moe_weight_conv_f8(Ctx& F, int l) {
    const Args& A = *F.a; const int i = l >> 1;
    LAS float* tile = (LAS float*)(F.lds);
    constexpr int T13 = (DM / 64) * (2 * D_EXP / 256), T2 = (D_EXP / 64) * (DM / 256), TE = T13 + T2;
    auto moe_args = [&](int it) -> ConvArgs { const int e = it / TE, r = it % TE; ConvArgs a;
        if (r < T13) { const int kb = r / (2 * D_EXP / 256), j = r % (2 * D_EXP / 256); const size_t so = ((size_t)i * NEXP + e) * DM * D_EXP;
            a = ConvArgs{INF(22) + so + j * 128, INF(23) + so + j * 128, D_EXP, 64 * kb, INF(17) + l * DM, pg8::F8_W1, (unsigned char*)(F.ws + WS_WE13) + (size_t)e * 2 * D_EXP * DM, DM, j * 256, true}; }
        else { const int r2 = r - T13, kb = r2 / (DM / 256), j = r2 % (DM / 256); const float* sp = INF(24) + ((size_t)i * NEXP + e) * D_EXP * DM + j * 256;
            a = ConvArgs{sp, sp + 128, DM, 64 * kb, nullptr, pg8::F8_W2, (unsigned char*)(F.ws + WS_WE2) + (size_t)e * DM * D_EXP, D_EXP, j * 256, true}; }
        return a; };
#define MOE_ARGS(it) moe_args(it)
    CONV_PIPE(F.vcu, NEXP * TE, F.G, MOE_ARGS);
#undef MOE_ARGS
}
__device__ __forceinline__ void h_to_fp8(Ctx& F) {
    const bf16* H = (const bf16*)(F.ws + WS_H); unsigned char* H8 = (unsigned char*)(F.ws + WS_H8);
    const int gw = F.vcu * NWAVES + F.wave, NGW = F.G * NWAVES;
    for (int m = gw; m < T; m += NGW) { const GAS v4u* hr = (const GAS v4u*)(H + (size_t)m * DM) + 2 * F.lane; const v4u a = hr[0], b = hr[1];
        v4u o; o.x = pg8::pk_fp8x4(pg8::bf_lo(a.x), pg8::bf_hi(a.x), pg8::bf_lo(a.y), pg8::bf_hi(a.y)); o.y = pg8::pk_fp8x4(pg8::bf_lo(a.z), pg8::bf_hi(a.z), pg8::bf_lo(a.w), pg8::bf_hi(a.w));
        o.z = pg8::pk_fp8x4(pg8::bf_lo(b.x), pg8::bf_hi(b.x), pg8::bf_lo(b.y), pg8::bf_hi(b.y)); o.w = pg8::pk_fp8x4(pg8::bf_lo(b.z), pg8::bf_hi(b.z), pg8::bf_lo(b.w), pg8::bf_hi(b.w));
        *((GAS v4u*)(H8 + (size_t)m * DM) + F.lane) = o; }
}
__device__ __forceinline__ void scan_phase(Ctx& F) {
    const float* logf = (const float*)(F.ws + WS_LOGF); float* cs2 = (float*)(F.ws + WS_CS2);
    LAS float* part = (LAS float*)(F.lds);
    for (int w = blockIdx.x; w < NB * 8; w += F.G) { const int b = w >> 3, hh = w & 7;
        float v[16]; float s = 0.f;
#pragma unroll
        for (int k = 0; k < 16; ++k) { s += logf[((size_t)b * SEQ + F.tid * 16 + k) * 8 + hh]; v[k] = s; }
        float incl = s;
#pragma unroll
        for (int o = 1; o < 64; o <<= 1) { const float y = __shfl_up(incl, o); if (F.lane >= o) incl += y; }
        if (F.lane == 63) part[F.wave] = incl;
        __syncthreads();
        float base = incl - s;
        for (int k = 0; k < F.wave; ++k) base += part[k];
        __syncthreads();
        float* op = cs2 + ((size_t)b * 8 + hh) * SEQ + F.tid * 16;
#pragma unroll
        for (int k = 0; k < 16; k += 4) *(f32x4*)(op + k) = (f32x4){-(base + v[k]) * LOG2E, -(base + v[k + 1]) * LOG2E, -(base + v[k + 2]) * LOG2E, -(base + v[k + 3]) * LOG2E};
    }
}
__device__ __forceinline__ void combine_phase(Ctx& F, int l) {
    const Args& A = *F.a;
    const float lam_init = 0.8f - 0.6f * expf(-0.3f * (float)l);
    const float d1 = wave_sum(INF(5)[l * 64 + F.lane] * INF(6)[l * 64 + F.lane], F.lane), d2 = wave_sum(INF(7)[l * 64 + F.lane] * INF(8)[l * 64 + F.lane], F.lane);
    const float lam = expf(d1) - expf(d2) + lam_init, post = 1.f - lam_init;
    const bf16* O1 = (const bf16*)(F.ob + OUT_O1); const bf16* O2 = (const bf16*)(F.ob + OUT_O2); bf16* MX = (bf16*)(F.ob + OUT_MIX);
    const float* g = INF(9) + l * 128 + (8 * F.lane & 127);
    const f32x4 g0 = *(const f32x4*)g, g1 = *(const f32x4*)(g + 4);
    const int gw = F.vcu * NWAVES + F.wave, NGW = F.G * NWAVES;
    for (int m = gw; m < T; m += NGW) {
        const v4u a = *(const GAS v4u*)(O1 + (size_t)m * 512 + 8 * F.lane), b = *(const GAS v4u*)(O2 + (size_t)m * 512 + 8 * F.lane);
        float d[8];
        d[0] = pg8::bf_lo(a.x) - lam * pg8::bf_lo(b.x); d[1] = pg8::bf_hi(a.x) - lam * pg8::bf_hi(b.x); d[2] = pg8::bf_lo(a.y) - lam * pg8::bf_lo(b.y); d[3] = pg8::bf_hi(a.y) - lam * pg8::bf_hi(b.y);
        d[4] = pg8::bf_lo(a.z) - lam * pg8::bf_lo(b.z); d[5] = pg8::bf_hi(a.z) - lam * pg8::bf_hi(b.z); d[6] = pg8::bf_lo(a.w) - lam * pg8::bf_lo(b.w); d[7] = pg8::bf_hi(a.w) - lam * pg8::bf_hi(b.w);
        float ss = 0.f;
#pragma unroll
        for (int k = 0; k < 8; ++k) ss += d[k] * d[k];
        ss += __shfl_xor(ss, 1); ss += __shfl_xor(ss, 2); ss += __shfl_xor(ss, 4); ss += __shfl_xor(ss, 8);
        const float r = rsqrtf(ss * (1.f / 128.f) + SUBLN_EPS) * post;
        v4u o; o.x = pk2(d[0] * r * g0[0], d[1] * r * g0[1]); o.y = pk2(d[2] * r * g0[2], d[3] * r * g0[3]); o.z = pk2(d[4] * r * g1[0], d[5] * r * g1[1]); o.w = pk2(d[6] * r * g1[2], d[7] * r * g1[3]);
        *(GAS v4u*)(MX + (size_t)m * DM + 8 * F.lane) = o;
    }
}
__device__ __forceinline__ void route_assign(Ctx& F) {
    const int* choice = (const int*)(F.ws + RT_CHOICE); const float* gates = (const float*)(F.ws + RT_GATES); const int* cnt = (const int*)(F.ws + RT_CNT);
    int* tok = (int*)(F.ws + RT_TOK); float* gate_s = (float*)(F.ws + RT_GATE_S); int* texp = (int*)(F.ws + RT_TEXP); int* ntl = (int*)(F.ws + RT_NT);
    LAS int* L = (LAS int*)(F.lds);
    for (int w = blockIdx.x; w < T / 256; w += F.G) {
        { const int e16 = F.tid & 15, ch = F.tid >> 4; int tot = 0, pre = 0;
          for (int k = 0; k < 8; ++k) { const int pm = ch * 8 + k; const int c = cnt[pm * 16 + e16]; tot += c; if (pm < w) pre += c; }
          L[ch * 16 + e16] = tot; L[512 + ch * 16 + e16] = pre; }
        __syncthreads();
        if (F.tid < 16) { int tot = 0, pre = 0; for (int ch = 0; ch < 32; ++ch) { tot += L[ch * 16 + F.tid]; pre += L[512 + ch * 16 + F.tid]; } L[1024 + F.tid] = tot; L[1040 + F.tid] = pre; L[1072 + F.tid] = 0; }
        __syncthreads();
        if (F.tid < 2) { int run = 0; for (int e = 0; e < 8; ++e) { L[1056 + F.tid * 8 + e] = run; run += ((L[1024 + F.tid * 8 + e] + 255) >> 8) << 8; } if (w == 0) ntl[F.tid] = run >> 8; }
        __syncthreads();
        int ch = 0, rk[2] = {0, 0};
        if (F.tid < 256) { ch = choice[w * 256 + F.tid];
            for (int idx = 0; idx < 16; ++idx) { const int s = idx >> 3; const bool mine = ((ch >> (8 * s)) & 255) == (idx & 7);
                const unsigned long long mk = __ballot(mine); if (mine) rk[s] = __popcll(mk & ((1ull << F.lane) - 1ull)); if (F.lane == 0) L[1088 + F.wave * 16 + idx] = __popcll(mk); } }
        __syncthreads();
        if (F.tid < 256) { const int t = w * 256 + F.tid;
#pragma unroll
            for (int s = 0; s < 2; ++s) { const int e = (ch >> (8 * s)) & 255; const int idx = s * 8 + e; int r = rk[s];
                for (int k = 0; k < F.wave; ++k) r += L[1088 + k * 16 + idx];
                const int slot = L[1056 + idx] + L[1040 + idx] + r; tok[s * MOE_ROWS + slot] = t; gate_s[s * MOE_ROWS + slot] = gates[(size_t)t * 2 + s]; } }
        if (w == 0) { for (int idx = F.tid; idx < 2 * 272; idx += NWAVES * 64) { const int s = idx / 272, tile = idx % 272; int ee = 0;
                for (int e = 0; e < 8; ++e) if ((L[1056 + s * 8 + e] >> 8) <= tile) ee = e;
                texp[s * 272 + tile] = ee; } }
        __syncthreads();
    }
}
struct SchedCross {
    const char* A; const char* B; char* O; int mode, G, c;
    __device__ __forceinline__ bool next(int i, pg8::Unit& u) const {
        if (!pg8::tile_order(i, G, c, T / 256, 4, u.pm, u.pn)) return false;
        const size_t t = ((size_t)u.pm * 256 * DM + (size_t)u.pn * 256) * 2; u.a = A + t; u.o = O + t; u.aux = u.pm * 256; u.ridx = nullptr;
        u.b = mode == 0 ? B + ((size_t)(u.pm >> 5) * 256 * DM + (size_t)u.pn * 256) * 2 : B + ((size_t)u.pn * 256 * (NB * NMEM) + (size_t)(u.pm >> 5) * 256) * 2; return true; }
};
struct SchedKV {
    unsigned char* ws; int G, c;
    __device__ __forceinline__ bool next(int i, pg8::Unit& u) const {
        const long L = (long)i * G + c; if (L >= 256) return false;
        const int l = (int)L >> 6, rem = (int)L & 63; const char* mn = (const char*)(ws + WS_MEMN) + (size_t)l * NB * NMEM * DM * 2; const char* w = (const char*)(ws + WS_WMKV) + (size_t)l * 2 * DM * DM * 2;
        u.aux = 0; u.ridx = nullptr;
        if (rem < 32) { u.pm = rem >> 2; u.pn = rem & 3; u.a = mn + (size_t)u.pm * 256 * DM * 2; u.b = w + (size_t)u.pn * 256 * DM * 2;
            u.o = (char*)(ws + WS_KM) + ((size_t)l * NB * NMEM * DM + (size_t)u.pm * 256 * DM + u.pn * 256) * 2; u.aux = DM; }
        else { const int r2 = rem - 32; u.pm = r2 >> 2; u.pn = r2 & 3; u.a = mn + (size_t)u.pm * 256 * DM * 2; u.b = w + (size_t)(DM + u.pn * 256) * DM * 2;
            u.o = (char*)(ws + WS_VT) + ((size_t)l * NB * NMEM * DM + (size_t)u.pm * 256 * DM + u.pn * 256) * 2; u.aux = DM; }
        return true; }
};
struct SchedXF {
    unsigned char* ws; int l, G, c, osz;
    __device__ __forceinline__ bool next(int i, pg8::Unit& u) const {
        const long L = (long)i * G + c; if (L >= 256) return false;
        const int r = (int)L & 127, b = r >> 4, h = (r >> 2) & 3, q4 = r & 3; u.pm = 0; u.pn = 0; u.aux = DM; u.ridx = nullptr;
        const size_t lm = (size_t)l * NB * NMEM * DM, lw = (size_t)l * DM * DM;
        if (L < 128) { u.a = (const char*)(ws + WS_KM) + (lm + (size_t)b * 256 * DM + h * 256) * 2; u.b = (const char*)(ws + WS_WMQ) + (lw + (size_t)q4 * 256 * DM + h * 256) * 2;
            u.o = (char*)(ws + WS_MT) + ((size_t)b * DM * DM + (size_t)h * 256 * DM + q4 * 256) * osz; }
        else { u.a = (const char*)(ws + WS_WMO) + (lw + (size_t)q4 * 256 * DM + h * 256) * 2; u.b = (const char*)(ws + WS_VT) + (lm + (size_t)b * 256 * DM + h * 256) * 2;
            u.o = (char*)(ws + WS_VWT) + ((size_t)b * DM * DM + (size_t)q4 * 256 * DM + h * 256) * osz; }
        return true; }
};
struct SchedCrossF {
    const char* A; const char* B; char* O; int G, c, esz, osz;
    __device__ __forceinline__ bool next(int i, pg8::Unit& u) const {
        if (!pg8::tile_order(i, G, c, T / 256, 4, u.pm, u.pn)) return false;
        u.a = A + (size_t)u.pm * 256 * DM * esz; u.b = B + ((size_t)(u.pm >> 5) * DM * DM + (size_t)u.pn * 256 * DM) * esz;
        u.o = O ? O + ((size_t)u.pm * 256 * DM + (size_t)u.pn * 256) * osz : nullptr; u.aux = u.pm * 256; u.ridx = nullptr; return true; }
};
struct SchedMoE {
    unsigned char* ws; const LAS int* texp; const int* tok; int nT, up, G, c, f8; size_t uoff; int rot;
    static constexpr int MSKIP = 4;
    __device__ __forceinline__ bool next(int i, pg8::Unit& u) const {
        long L;
        if (rot == 0) L = (long)i * G + c;
        else { const int rd = c < rot ? i + MSKIP : i; L = rd < MSKIP ? (long)rd * (G - rot) + (c - rot) : (long)MSKIP * (G - rot) + (long)(rd - MSKIP) * G + c; }
        if (!pg8::tile_of(L, nT, up ? 28 : 4, u.pm, u.pn)) return false;
        const int e = __builtin_amdgcn_readfirstlane(texp[u.pm]); u.aux = u.pm * 256; u.o = nullptr;
        const size_t eb = f8 ? 1 : 2;
        if (up) { u.a = (const char*)(ws + (f8 ? WS_H8 : WS_H)); u.ridx = tok + u.pm * 256; u.b = (const char*)(ws + WS_WE13) + ((size_t)e * 2 * D_EXP + (size_t)u.pn * 256) * DM * eb; }
        else { u.a = (const char*)(ws + WS_R) + uoff + (size_t)u.pm * 256 * D_EXP * eb; u.ridx = nullptr; u.b = (const char*)(ws + WS_WE2) + ((size_t)e * DM + (size_t)u.pn * 256) * D_EXP * eb; }
        return true; }
};

#ifndef MK_MULTI
#define MK_MULTI 0
#endif
__global__ void __launch_bounds__(NWAVES * 64, 2) fwd(Args args) {
    extern __shared__ __attribute__((aligned(16))) unsigned char lds[];
    Ctx F;
    F.lds = (LAS unsigned char*)lds; F.tid = threadIdx.x; F.lane = F.tid & 63; F.wave = __builtin_amdgcn_readfirstlane(F.tid >> 6);
    F.G = gridDim.x; { const int bx = blockIdx.x; F.vcu = (F.G % 8 == 0) ? (bx % 8) * (F.G / 8) + bx / 8 : bx; }
    F.a = &args; F.ws = args.ws; F.ob = (unsigned char*)args.out;
    const Args& A = args;
    unsigned char* ws = args.ws;
    for (int u = F.tid; u < (LDS_BYTES - LDSCTL_OFF) / 4; u += NWAVES * 64) ((LAS unsigned*)(F.lds + LDSCTL_OFF))[u] = 0u;
    __syncthreads();
    volatile LAS unsigned* MISC = (volatile LAS unsigned*)(F.lds + MISC_OFF);
    XcdBarrier bar = xcd_barrier_post((unsigned*)(ws + WS_CTL) + CW_BAR, MISC + 8);
    const int lo = args.ph_lo, hi = args.ph_hi; int ph = 0;
#ifndef MK_MASK
#define MK_MASK 0xFFFFFFFFu
#endif
#define EN(k) (((MK_MASK) >> (k)) & 1u)
#define PH_ON (ph >= lo && ph < hi)
#define PH_END do { if (ph >= lo && ph + 1 < hi) xcd_barrier(bar); ++ph; } while (0)
    LAS unsigned char* ring = F.lds;
    const int bx0 = (int)blockIdx.x; unsigned char* const ws0 = ws;
    const size_t TILE_D = (size_t)256 * DM * 2;
#define PH_LOCALS int bx = bx0; unsigned char* ws = ws0; asm volatile("" : "+s"(bx), "+s"(ws)); \
    float* ssq_mix = (float*)(ws + WS_SSQ); float* ssq_mem = ssq_mix + (size_t)T * 16; float* ssq_ffn = ssq_mix + (size_t)2 * T * 16; bf16* H = (bf16*)(ws + WS_H); \
    Ctx Fl = F; Fl.ws = ws; Fl.tid = (int)threadIdx.x; asm volatile("" : "+v"(Fl.tid)); Fl.lane = Fl.tid & 63; Fl.wave = __builtin_amdgcn_readfirstlane(Fl.tid >> 6); asm volatile("" : "+s"(Fl.vcu), "+s"(Fl.G)); \
    const __attribute__((address_space(4))) Args* ap_ = (const __attribute__((address_space(4))) Args*)__builtin_amdgcn_kernarg_segment_ptr(); asm volatile("" : "+s"(ap_)); \
    Args A_; _Pragma("unroll") for (int i_ = 0; i_ < 26; ++i_) A_.in[i_] = ap_->in[i_]; A_.out = ap_->out; A_.ws = ap_->ws; A_.ph_lo = ap_->ph_lo; A_.ph_hi = ap_->ph_hi; Fl.a = &A_; const Args& A = A_; (void)A; \
    (void)ssq_mix; (void)ssq_mem; (void)ssq_ffn; (void)H; (void)bx;

    if (PH_ON && EN(0)) { PH_LOCALS p0_prologue(Fl); }
    PH_END;
    if (PH_ON && EN(1)) { PH_LOCALS SchedKV S{ws, Fl.G, bx}; pg8::EpiPlain<false, DM> E{nullptr, 1.f}; pg8::gemm_phase<pg8::EpiPlain<false, DM>, SchedKV, false>(ring, pg8::Gemm{DM, DM, DM}, S, E, (LAS float*)(Fl.lds + LDSR_OFF)); }
    PH_END;

    for (int l = 0; l < DEPTH; ++l) {
        const bool dense8 = ((l & 1) == 0) && ((MK_DENSE8 >> (l >> 1)) & 1), need_h8 = (l & 1) || dense8;
        if (PH_ON && EN(2)) { PH_LOCALS
            pg8::SchedDense S{(const char*)H, (const char*)(ws + WS_WIN) + (size_t)l * D_INP * DM * 2, nullptr, TILE_D, TILE_D, 0, T / 256, D_INP / 256, Fl.G, bx};
            pg8::EpiIn E{(bf16*)(ws + WS_R), ssq_mix, (const float*)(ws + WS_COS), (const float*)(ws + WS_SIN), (float*)(ws + WS_LOGF), INF(10) + l * 8, (unsigned*)(ws + WS_CTL) + CW_KMX + l * 128};
            pg8::gemm_phase<pg8::EpiIn, pg8::SchedDense, false>(ring, pg8::Gemm{DM, DM, DM}, S, E, (LAS float*)(Fl.lds + LDSR_OFF));
        }
        PH_END;
        if (PH_ON && EN(3)) { PH_LOCALS scan_phase(Fl); if (l & 1) moe_weight_conv_f8(Fl, l);
            __syncthreads();
            SchedXF S{ws, l, Fl.G, bx, 1}; pg8::EpiPlain8<DM> E{pg8::F8_X};
            pg8::gemm_phase<pg8::EpiPlain8<DM>, SchedXF, false>(ring, pg8::Gemm{DM, DM, 256}, S, E, (LAS float*)(Fl.lds + LDSR_OFF)); }
        PH_END;
        if (PH_ON && EN(4)) { PH_LOCALS
            const attn_body::bf16* QKV = (const attn_body::bf16*)(ws + WS_R);
            const int ngr = Fl.G / 8, g = Fl.vcu >> 3, s = Fl.vcu & 7;
            { const float lam_init = 0.8f - 0.6f * expf(-0.3f * (float)l);
              const float d1 = wave_sum(INF(5)[l * 64 + Fl.lane] * INF(6)[l * 64 + Fl.lane], Fl.lane), d2 = wave_sum(INF(7)[l * 64 + Fl.lane] * INF(8)[l * 64 + Fl.lane], Fl.lane);
              const float lam = expf(d1) - expf(d2) + lam_init, post = 1.f - lam_init;
              for (int p = g; p < NB * 4; p += ngr) { const int b = p >> 2, head = p & 3; const attn_body::bf16* base = QKV + (size_t)b * SEQ * QKVP;
                attn_body::bf16* O1 = (attn_body::bf16*)(Fl.ob + OUT_O1) + (size_t)b * SEQ * 512 + head * 128;
                attn_body::bf16* MX = (attn_body::bf16*)(Fl.ob + OUT_MIX) + (size_t)b * SEQ * DM + head * 128;
                for (int mi = 0; mi < 8; ++mi) { const int m = mi >> 2, i = mi & 3, qb = (i == 0) ? s : (i == 1) ? 15 - s : (i == 2) ? 16 + s : 31 - s;
                    attn_body::diff_unit2<8>(qb, base + m * 256 + head * 64, base + 512 + m * 256 + head * 64, base + 1024 + head * 128, m ? MX : O1, m ? DM : 512, m ? O1 : nullptr, lam, post, INF(9) + l * 128, (char*)lds); } } }
            for (int p = g; p < NB * 8; p += ngr) { const int b = p >> 3, jf = p & 7; const attn_body::bf16* base = QKV + (size_t)b * SEQ * QKVP;
                attn_body::bf16* O = (attn_body::bf16*)(Fl.ob + OUT_MIX) + (size_t)b * SEQ * DM + 512 + jf * 64;
                const float* bias = (const float*)(ws + WS_CS2) + ((size_t)b * 8 + jf) * SEQ;
                const unsigned* kmx = (const unsigned*)(ws + WS_CTL) + CW_KMX + l * 128 + b * 16 + jf * 2;
                const float kmaxn = __builtin_sqrtf(__uint_as_float(__builtin_amdgcn_readfirstlane(__hip_atomic_load(kmx, __ATOMIC_RELAXED, __HIP_MEMORY_SCOPE_AGENT))) + __uint_as_float(__builtin_amdgcn_readfirstlane(__hip_atomic_load(kmx + 1, __ATOMIC_RELAXED, __HIP_MEMORY_SCOPE_AGENT))));
                for (int i = 0; i < 4; ++i) { const int qb = (i == 0) ? s : (i == 1) ? 15 - s : (i == 2) ? 16 + s : 31 - s;
                    attn_body::fox_unit<8>(qb, base + 1536 + jf * 64, base + 2048 + jf * 64, base + 2560 + jf * 64, O, DM, bias, kmaxn, (char*)lds); } }
        }
        PH_END;
        if (PH_ON && EN(6)) { PH_LOCALS
            pg8::SchedDense S{(const char*)(Fl.ob + OUT_MIX), (const char*)(ws + WS_WOUT) + (size_t)l * DM * DM * 2, nullptr, TILE_D, TILE_D, 0, T / 256, 4, Fl.G, bx};
            pg8::EpiRes<false> E{H, ssq_mem, nullptr, nullptr, (unsigned char*)(ws + WS_H8), 1.f};
            pg8::gemm_phase<pg8::EpiRes<false>, pg8::SchedDense, false>(ring, pg8::Gemm{DM, DM, DM}, S, E, (LAS float*)(Fl.lds + LDSR_OFF));
        }
        PH_END;
        if (PH_ON && EN(7)) { PH_LOCALS
            SchedCrossF S{(const char*)(ws + WS_H8), (const char*)(ws + WS_MT), (char*)(ws + WS_R), Fl.G, bx, 1, 1};
            pg8::EpiSoftmax<true> E{(LAS float*)(Fl.lds + LDSX_OFF), ssq_mem, CM * (1.f / pg8::F8_X)};
            pg8::gemm_phase<pg8::EpiSoftmax<true>, SchedCrossF, false, true>(ring, pg8::Gemm{DM / 2, DM / 2, DM / 2}, S, E, (LAS float*)(Fl.lds + LDSR_OFF));
        }
        PH_END;
        if (PH_ON && EN(10)) { PH_LOCALS
            SchedCrossF S{(const char*)(ws + WS_R), (const char*)(ws + WS_VWT), nullptr, Fl.G, bx, 1, 1};
            pg8::EpiRes<false> E{H, ssq_ffn, nullptr, nullptr, need_h8 ? (unsigned char*)(ws + WS_H8) : nullptr, 1.f / (pg8::F8_P * pg8::F8_X)};
            pg8::gemm_phase<pg8::EpiRes<false>, SchedCrossF, false, true>(ring, pg8::Gemm{DM / 2, DM / 2, DM / 2}, S, E, (LAS float*)(Fl.lds + LDSR_OFF));
        }
        PH_END;
        if ((l & 1) == 0) {
            const int i = l >> 1;
            if (PH_ON && EN(11)) { PH_LOCALS
                if (dense8) {
                    pg8::SchedDense S{(const char*)(ws + WS_H8), (const char*)(ws + WS_WFF13) + (size_t)i * 2 * D_FF * DM * 2, nullptr, (size_t)256 * DM, (size_t)256 * DM, 0, T / 256, 2 * D_FF / 256, Fl.G, bx};
                    pg8::EpiSwiglu8<false, D_FF> E{(unsigned char*)(ws + WS_R), ssq_ffn, nullptr};
                    pg8::gemm_phase<pg8::EpiSwiglu8<false, D_FF>, pg8::SchedDense, false, true>(ring, pg8::Gemm{DM / 2, DM / 2, DM / 2}, S, E, (LAS float*)(Fl.lds + LDSR_OFF));
                } else {
                pg8::SchedDense S{(const char*)H, (const char*)(ws + WS_WFF13) + (size_t)i * 2 * D_FF * DM * 2, nullptr, TILE_D, TILE_D, 0, T / 256, 2 * D_FF / 256, Fl.G, bx};
                pg8::EpiSwiglu<false, D_FF> E{(bf16*)(ws + WS_R), ssq_ffn, nullptr};
                pg8::gemm_phase<pg8::EpiSwiglu<false, D_FF>, pg8::SchedDense, false>(ring, pg8::Gemm{DM, DM, DM}, S, E, (LAS float*)(Fl.lds + LDSR_OFF));
                }
            }
            PH_END;
            if (PH_ON && EN(12)) { PH_LOCALS
                if (dense8) {
                    pg8::SchedDense S{(const char*)(ws + WS_R), (const char*)(ws + WS_WFF2) + (size_t)i * DM * D_FF * 2, nullptr, (size_t)256 * D_FF, (size_t)256 * D_FF, 0, T / 256, 4, Fl.G, bx};
                    pg8::EpiRes<false> E{H, ssq_mix, nullptr, nullptr, nullptr, 1.f / (pg8::F8_W2 * pg8::F8_U)};
                    pg8::gemm_phase<pg8::EpiRes<false>, pg8::SchedDense, false, true>(ring, pg8::Gemm{D_FF / 2, D_FF / 2, D_FF / 2}, S, E, (LAS float*)(Fl.lds + LDSR_OFF));
                } else {
                pg8::SchedDense S{(const char*)(ws + WS_R), (const char*)(ws + WS_WFF2) + (size_t)i * DM * D_FF * 2, nullptr, (size_t)256 * D_FF * 2, (size_t)256 * D_FF * 2, 0, T / 256, 4, Fl.G, bx};
                pg8::EpiRes<false> E{H, ssq_mix, nullptr, nullptr, nullptr, 1.f};
                pg8::gemm_phase<pg8::EpiRes<false>, pg8::SchedDense, false>(ring, pg8::Gemm{D_FF, D_FF, D_FF}, S, E, (LAS float*)(Fl.lds + LDSR_OFF));
                }
            }
            PH_END;
        } else {
            const int i = l >> 1;
            if (PH_ON && EN(13)) { PH_LOCALS
                { int* tok = (int*)(ws + RT_TOK); for (int k = bx * NWAVES * 64 + Fl.tid; k < 2 * MOE_ROWS; k += Fl.G * NWAVES * 64) tok[k] = -1; }
                pg8::SchedDense S{(const char*)H, (const char*)(ws + WS_WRT) + (size_t)i * 256 * DM * 2, nullptr, TILE_D, TILE_D, 0, T / 256, 1, Fl.G, bx};
                pg8::EpiRouter E{ssq_ffn, (int*)(ws + RT_CHOICE), (float*)(ws + RT_GATES), (int*)(ws + RT_CNT), (LAS int*)(Fl.lds + LDSH_OFF)};
                pg8::gemm_phase<pg8::EpiRouter, pg8::SchedDense, false>(ring, pg8::Gemm{DM, DM, DM}, S, E, (LAS float*)(Fl.lds + LDSR_OFF));
            }
            PH_END;
            if (PH_ON && EN(14)) { PH_LOCALS route_assign(Fl); }
            PH_END;
            for (int st = 0; st < 3; ++st) {
                if (PH_ON && EN(15)) { PH_LOCALS
                    LAS int* tl = (LAS int*)(Fl.lds + LDSX_OFF); int rot = 0;
                    if (st >= 1) {
                        const int sd = st - 1; const int* tok = (const int*)(ws + RT_TOK) + sd * MOE_ROWS; const int* texp = (const int*)(ws + RT_TEXP) + sd * 272;
                        const int nT = __builtin_amdgcn_readfirstlane(((const int*)(ws + RT_NT))[sd]);
                        if (Fl.tid < 272) tl[Fl.tid] = texp[Fl.tid]; __syncthreads();
                        SchedMoE S{ws, tl, tok, nT, 0, Fl.G, bx, 1, (size_t)sd * MOE_ROWS * D_EXP, 0};
                        pg8::EpiMoeDown E{H, (bf16*)(Fl.ob), ssq_mix, tok, (const float*)(ws + RT_GATE_S) + sd * MOE_ROWS, sd, 1.f / (pg8::F8_W2 * pg8::F8_U)};
                        pg8::gemm_phase<pg8::EpiMoeDown, SchedMoE, false, true>(ring, pg8::Gemm{D_EXP / 2, D_EXP / 2, D_EXP / 2}, S, E, (LAS float*)(Fl.lds + LDSR_OFF));
                        rot = ((nT * 4) % Fl.G + 7) & ~7;
                    }
                    if (st <= 1) {
                        const int* tok = (const int*)(ws + RT_TOK) + st * MOE_ROWS; const int* texp = (const int*)(ws + RT_TEXP) + st * 272;
                        const int nT = __builtin_amdgcn_readfirstlane(((const int*)(ws + RT_NT))[st]);
                        if (Fl.tid < 272) tl[Fl.tid] = texp[Fl.tid]; __syncthreads();
                        SchedMoE S{ws, tl, tok, nT, 1, Fl.G, bx, 1, 0, rot};
                        pg8::EpiSwiglu8<true, D_EXP> E{(unsigned char*)(ws + WS_R) + (size_t)st * MOE_ROWS * D_EXP, ssq_ffn, tok};
                        pg8::gemm_phase<pg8::EpiSwiglu8<true, D_EXP>, SchedMoE, true, true>(ring, pg8::Gemm{DM / 2, DM / 2, DM / 2}, S, E, (LAS float*)(Fl.lds + LDSR_OFF));
                    }
                }
                PH_END;
            }
        }
    }
    if (PH_ON && EN(17)) { PH_LOCALS
        const float* g = INF(25); const int gw = Fl.vcu * NWAVES + Fl.wave, NGW = Fl.G * NWAVES;
        const unsigned tmo = __hip_atomic_load((unsigned*)(ws + WS_CTL) + CW_BAR + XB_TMO, RLX_AGENT);
        f32x4 gg[4];
#pragma unroll
        for (int j = 0; j < 4; ++j) gg[j] = *((const GAS f32x4*)g + Fl.lane + 64 * j);
        for (int m0 = gw * 4; m0 < T; m0 += NGW * 4) {
            unsigned long long w[4][4]; float rs[4];
#pragma unroll
            for (int r = 0; r < 4; ++r) { const int m = m0 + r; rs[r] = pg8::rstd16((const f32x4*)(ssq_mix + (size_t)m * 16));
                const GAS unsigned long long* hr = (const GAS unsigned long long*)(H + (size_t)m * DM) + Fl.lane;
#pragma unroll
                for (int j = 0; j < 4; ++j) w[r][j] = hr[64 * j]; }
#pragma unroll
            for (int r = 0; r < 4; ++r) { GAS f32x4* o = (GAS f32x4*)(args.out + (size_t)(m0 + r) * DM) + Fl.lane;
#pragma unroll
                for (int j = 0; j < 4; ++j) { const unsigned a = (unsigned)w[r][j], b = (unsigned)(w[r][j] >> 32);
                    f32x4 v = {pg8::bf_lo(a) * rs[r] * gg[j].x, pg8::bf_hi(a) * rs[r] * gg[j].y, pg8::bf_lo(b) * rs[r] * gg[j].z, pg8::bf_hi(b) * rs[r] * gg[j].w};
                    if (tmo) v = (f32x4){__builtin_nanf(""), __builtin_nanf(""), __builtin_nanf(""), __builtin_nanf("")};
                    o[64 * j] = v; } } }
    }
    PH_END;
#undef PH_ON
#undef PH_END
#undef PH_LOCALS
}

#ifndef MK_STOP
#define MK_STOP 0
#endif
#ifndef MK_DUMP_OFF
#define MK_DUMP_OFF WS_H
#endif
#ifndef MK_DUMP_INTS
#define MK_DUMP_INTS 0
#endif
__global__ void dump_i32(const int* src, float* out, size_t nint, size_t n) {
    for (size_t i = (size_t)blockIdx.x * blockDim.x + threadIdx.x; i < n; i += (size_t)gridDim.x * blockDim.x) out[i] = i < nint ? (float)src[i] : 0.f;
}
__global__ void dump_bf16(const unsigned short* src, float* out, size_t n) {
    for (size_t i = (size_t)blockIdx.x * blockDim.x + threadIdx.x; i < n; i += (size_t)gridDim.x * blockDim.x) out[i] = __uint_as_float((unsigned)src[i] << 16);
}
extern "C" void kernel_launch(void* const* d_in, const int* in_sizes, int n_in, void* d_out, int out_size, void* d_ws, size_t ws_size, hipStream_t stream) {
    static int grid = 0;
    if (grid == 0) {
        if (n_in != 26 || out_size != T * DM || ws_size < WS_END) { fprintf(stderr, "kernel_launch: unexpected shapes (n_in %d, out %d, ws %zu < %zu)\n", n_in, out_size, ws_size, (size_t)WS_END); grid = -1; return; }
        int dev = 0, cus = 0, per_cu = 0;
        if (hipGetDevice(&dev) != hipSuccess || hipDeviceGetAttribute(&cus, hipDeviceAttributeMultiprocessorCount, dev) != hipSuccess) { grid = -1; return; }
        if (hipFuncSetAttribute((const void*)fwd, hipFuncAttributeMaxDynamicSharedMemorySize, LDS_BYTES) != hipSuccess) { fprintf(stderr, "kernel_launch: hipFuncSetAttribute failed\n"); grid = -1; return; }
        if (hipOccupancyMaxActiveBlocksPerMultiprocessor(&per_cu, (const void*)fwd, NWAVES * 64, LDS_BYTES) != hipSuccess || per_cu < 1) fprintf(stderr, "kernel_launch: occupancy query reports %d\n", per_cu);
        (void)hipGetLastError();
        grid = cus;
    }
    if (grid < 0) return;
    if (hipMemsetAsync((char*)d_ws + WS_CTL, 0, CTL_ZERO_BYTES, stream) != hipSuccess) return;
    Args a{};
    for (int i = 0; i < 26; ++i) a.in[i] = d_in[i];
    a.out = (float*)d_out; a.ws = (unsigned char*)d_ws;
#if MK_MULTI
    const int nph = MK_STOP ? MK_STOP : 2 + 8 + 12 + 8 + 12 + 1;
    for (int p = 0; p < nph; ++p) { a.ph_lo = p; a.ph_hi = p + 1; hipLaunchKernelGGL(fwd, dim3(grid), dim3(NWAVES * 64), LDS_BYTES, stream, a); }
    if (MK_STOP && MK_DUMP_INTS) hipLaunchKernelGGL(dump_i32, dim3(2048), dim3(256), 0, stream, (const int*)((const char*)d_ws + (MK_DUMP_OFF)), (float*)d_out, (size_t)(MK_DUMP_INTS), (size_t)T * DM);
    else if (MK_STOP) hipLaunchKernelGGL(dump_bf16, dim3(2048), dim3(256), 0, stream, (const unsigned short*)((const char*)d_ws + (MK_DUMP_OFF)), (float*)d_out, (size_t)T * DM);
#else
    a.ph_lo = 0; a.ph_hi = 1 << 30;
    hipLaunchKernelGGL(fwd, dim3(grid), dim3(NWAVES * 64), LDS_BYTES, stream, a);
#endif
    const hipError_t le = hipPeekAtLastError();
    if (le != hipSuccess) fprintf(stderr, "kernel_launch: launch failed: %s\n", hipGetErrorName(le));
}
```
